# Optimizing an MI355X kernel written in HIP

```python
import jax, jax.numpy as jnp
from jax import lax
import numpy as np

D_MODEL = 1024
BATCH = 8
SEQ = 2048
DEPTH = 1

N_MEM = 256
SB_HEADS = 8
SB_HEAD_DIM = 64
DSA_HEADS = 8
DSA_KV_HEADS = 2
DSA_HEAD_DIM = 64
IDX_HEADS = 8
IDX_HEAD_DIM = 64
TOPK_MAX = 256
MEM_HEADS = 4
MEM_HEAD_DIM = 128
D_FF = 4 * D_MODEL
Q_BLOCK = 128
ROPE_THETA = 10000.0
EPS = 1e-6

IN_WIDTHS = (
    SB_HEADS * SB_HEAD_DIM,
    SB_HEADS * SB_HEAD_DIM,
    SB_HEADS * SB_HEAD_DIM,
    DSA_HEADS * DSA_HEAD_DIM,
    DSA_KV_HEADS * DSA_HEAD_DIM,
    DSA_KV_HEADS * DSA_HEAD_DIM,
    IDX_HEADS * IDX_HEAD_DIM,
    IDX_HEAD_DIM,
    IDX_HEADS,
)
D_IN = int(sum(IN_WIDTHS))
IN_OFFSETS = [int(o) for o in np.cumsum(IN_WIDTHS)[:-1]]

kernel_name = "hybrid_stickbreak_dsa_gated_block"


def _rmsnorm(x, g):
    x32 = x.astype(jnp.float32)
    y = x32 * lax.rsqrt(jnp.mean(x32 * x32, axis=-1, keepdims=True) + EPS)
    return (y * g.astype(jnp.float32)).astype(x.dtype)


def _rope(x, pos):
    d = x.shape[-1]
    inv = ROPE_THETA ** (-jnp.arange(0, d, 2, dtype=jnp.float32) / d)
    ang = pos.astype(jnp.float32)[:, None] * inv[None, :]
    cos = jnp.cos(ang)[None, :, None, :]
    sin = jnp.sin(ang)[None, :, None, :]
    x32 = x.astype(jnp.float32)
    x1, x2 = x32[..., : d // 2], x32[..., d // 2:]
    out = jnp.concatenate([x1 * cos - x2 * sin, x2 * cos + x1 * sin], axis=-1)
    return out.astype(x.dtype)


def _to_blocks(a):
    b, s = a.shape[:2]
    return jnp.moveaxis(a.reshape(b, s // Q_BLOCK, Q_BLOCK, *a.shape[2:]), 1, 0)


def _from_blocks(a):
    nb, b, qb = a.shape[:3]
    return jnp.moveaxis(a, 0, 1).reshape(b, nb * qb, *a.shape[3:])


def _stick_breaking_attention(q, k, v):
    b, s, h, dh = q.shape
    scale = dh ** -0.5
    key_pos = jnp.arange(s)
    t_blocks = jnp.arange(s).reshape(s // Q_BLOCK, Q_BLOCK)

    def block(args):
        qb, t_idx = args
        z = jnp.einsum('bqhd,bkhd->bhqk', qb, k).astype(jnp.float32) * scale
        strict = (key_pos[None, :] < t_idx[:, None])[None, None]
        log_beta = jax.nn.log_sigmoid(z)
        log_1mb = jnp.where(strict, jax.nn.log_sigmoid(-z), 0.0)
        suffix = lax.cumsum(log_1mb, axis=3, reverse=True) - log_1mb
        a = jnp.where(strict, jnp.exp(log_beta + suffix), 0.0)
        return jnp.einsum('bhqk,bkhd->bqhd', a.astype(v.dtype), v)

    out = lax.map(block, (_to_blocks(q), t_blocks))
    return _from_blocks(out).reshape(b, s, h * dh)


def _dsa_attention(q, k, v, iq, ik, iw):
    b, s, h, dh = q.shape
    g = k.shape[2]
    r = h // g
    k_top = min(TOPK_MAX, s // 4)
    scale = dh ** -0.5
    idx_scale = iq.shape[-1] ** -0.5
    w_scale = iw.shape[-1] ** -0.5
    key_pos = jnp.arange(s)
    t_blocks = jnp.arange(s).reshape(s // Q_BLOCK, Q_BLOCK)

    def block(args):
        qb, iqb, iwb, t_idx = args
        dots = jnp.einsum('bqhd,bkd->bqhk', iqb, ik).astype(jnp.float32) * idx_scale
        score = jnp.einsum('bqhk,bqh->bqk', jax.nn.relu(dots),
                           iwb.astype(jnp.float32) * w_scale)
        causal = (key_pos[None, :] <= t_idx[:, None])[None]
        score = jnp.where(causal, score, -jnp.inf)
        vals, sel = lax.top_k(score, k_top)
        valid = jnp.isfinite(vals)
        kg = jax.vmap(lambda kk, ii: kk[ii])(k, sel)
        vg = jax.vmap(lambda vv, ii: vv[ii])(v, sel)
        qg = qb.reshape(b, Q_BLOCK, g, r, dh)
        logits = jnp.einsum('bqgrd,bqkgd->bqgrk', qg, kg).astype(jnp.float32) * scale
        logits = jnp.where(valid[:, :, None, None, :], logits, -jnp.inf)
        p = jax.nn.softmax(logits, axis=-1)
        o = jnp.einsum('bqgrk,bqkgd->bqgrd', p.astype(vg.dtype), vg)
        return o.reshape(b, Q_BLOCK, h * dh)

    out = lax.map(block, (_to_blocks(q), _to_blocks(iq), _to_blocks(iw), t_blocks))
    return _from_blocks(out)


def _token_mixer(u, w_in, w_branch_sb, w_branch_dsa, w_gate, b_gate, w_out):
    b, s, _ = u.shape
    pos = jnp.arange(s)
    proj = u @ w_in
    sb_q, sb_k, sb_v, dq, dk, dv, iq, ik, iw = jnp.split(proj, IN_OFFSETS, axis=-1)
    sb_q = sb_q.reshape(b, s, SB_HEADS, SB_HEAD_DIM)
    sb_k = sb_k.reshape(b, s, SB_HEADS, SB_HEAD_DIM)
    sb_v = sb_v.reshape(b, s, SB_HEADS, SB_HEAD_DIM)
    dq = _rope(dq.reshape(b, s, DSA_HEADS, DSA_HEAD_DIM), pos)
    dk = _rope(dk.reshape(b, s, DSA_KV_HEADS, DSA_HEAD_DIM), pos)
    dv = dv.reshape(b, s, DSA_KV_HEADS, DSA_HEAD_DIM)
    iq = _rope(iq.reshape(b, s, IDX_HEADS, IDX_HEAD_DIM), pos)
    ik = _rope(ik[:, :, None, :], pos)[:, :, 0, :]

    o_sb = _stick_breaking_attention(sb_q, sb_k, sb_v)
    o_dsa = _dsa_attention(dq, dk, dv, iq, ik, iw)

    gates = jax.nn.sigmoid((u @ w_gate + b_gate).astype(jnp.float32)).astype(u.dtype)
    g_sb, g_dsa = jnp.split(gates, 2, axis=-1)
    merged = g_sb * (o_sb @ w_branch_sb) + g_dsa * (o_dsa @ w_branch_dsa)
    return merged @ w_out


def _memory_cross_attention(u, mem_n, w_cq, w_ckv, w_co):
    b, s, _ = u.shape
    m = mem_n.shape[1]
    q = (u @ w_cq).reshape(b, s, MEM_HEADS, MEM_HEAD_DIM)
    k, v = jnp.split(mem_n @ w_ckv, 2, axis=-1)
    k = k.reshape(b, m, MEM_HEADS, MEM_HEAD_DIM)
    v = v.reshape(b, m, MEM_HEADS, MEM_HEAD_DIM)
    logits = jnp.einsum('bqhd,bmhd->bhqm', q, k).astype(jnp.float32) * MEM_HEAD_DIM ** -0.5
    p = jax.nn.softmax(logits, axis=-1)
    o = jnp.einsum('bhqm,bmhd->bqhd', p.astype(v.dtype), v)
    return o.reshape(b, s, MEM_HEADS * MEM_HEAD_DIM) @ w_co


def _squared_relu_mlp(u, w_up, w_down):
    hdn = jax.nn.relu(u @ w_up)
    return (hdn * hdn) @ w_down


def setup_inputs(seed: int = 0) -> dict:
    key = jax.random.key(seed)
    ks = jax.random.split(key, 20)

    def dense(k, fan_in, fan_out):
        return jax.random.normal(k, (DEPTH, fan_in, fan_out), jnp.float32) * fan_in ** -0.5

    def gain(k, n, depth=True):
        shape = (DEPTH, n) if depth else (n,)
        return 1.0 + 0.02 * jax.random.normal(k, shape, jnp.float32)

    return {
        "x": jax.random.normal(ks[0], (BATCH, SEQ, D_MODEL), jnp.float32),
        "mem": jax.random.normal(ks[1], (BATCH, N_MEM, D_MODEL), jnp.float32),
        "norm_mix": gain(ks[2], D_MODEL),
        "w_in": dense(ks[3], D_MODEL, D_IN),
        "w_branch_sb": dense(ks[4], SB_HEADS * SB_HEAD_DIM, D_MODEL),
        "w_branch_dsa": dense(ks[5], DSA_HEADS * DSA_HEAD_DIM, D_MODEL),
        "w_gate": dense(ks[6], D_MODEL, 2 * D_MODEL),
        "b_gate": 0.01 * jax.random.normal(ks[7], (DEPTH, 2 * D_MODEL), jnp.float32),
        "w_out": dense(ks[8], D_MODEL, D_MODEL),
        "norm_cross": gain(ks[9], D_MODEL),
        "norm_mem": gain(ks[10], D_MODEL),
        "w_cq": dense(ks[11], D_MODEL, MEM_HEADS * MEM_HEAD_DIM),
        "w_ckv": dense(ks[12], D_MODEL, 2 * MEM_HEADS * MEM_HEAD_DIM),
        "w_co": dense(ks[13], MEM_HEADS * MEM_HEAD_DIM, D_MODEL),
        "norm_mlp": gain(ks[14], D_MODEL),
        "w_up": dense(ks[15], D_MODEL, D_FF),
        "w_down": dense(ks[16], D_FF, D_MODEL),
        "norm_final": gain(ks[17], D_MODEL, depth=False),
    }


def reference(x, mem, norm_mix, w_in, w_branch_sb, w_branch_dsa, w_gate, b_gate, w_out,
              norm_cross, norm_mem, w_cq, w_ckv, w_co, norm_mlp, w_up, w_down, norm_final):
    h = x
    for l in range(DEPTH):
        u = _rmsnorm(h, norm_mix[l])
        h = h + _token_mixer(u, w_in[l], w_branch_sb[l], w_branch_dsa[l],
                             w_gate[l], b_gate[l], w_out[l])
        u = _rmsnorm(h, norm_cross[l])
        mem_n = _rmsnorm(mem, norm_mem[l])
        h = h + _memory_cross_attention(u, mem_n, w_cq[l], w_ckv[l], w_co[l])
        u = _rmsnorm(h, norm_mlp[l])
        h = h + _squared_relu_mlp(u, w_up[l], w_down[l])
    return _rmsnorm(h, norm_final)
```

```cpp
#include <hip/hip_runtime.h>
#include <hip/hip_cooperative_groups.h>
#include <cstdio>
#include <cstdint>
namespace cg = cooperative_groups;

#define DEVINL __device__ __forceinline__
typedef unsigned short bf16_t;
typedef short bf16x8 __attribute__((ext_vector_type(8)));
typedef float f32x4 __attribute__((ext_vector_type(4)));

constexpr int NTHREADS = 512;
constexpr int LDS_BYTES = 159744;
constexpr float EPS = 1e-6f;
constexpr size_t MB = 1u << 20;

constexpr size_t OFF_SBQ = 0 * MB, OFF_SBK = 16 * MB, OFF_SBVT = 32 * MB, OFF_DQ = 48 * MB, OFF_DK = 64 * MB, OFF_DVT = 68 * MB,
                 OFF_IQ = 72 * MB, OFF_IK = 88 * MB, OFF_GATES = 90 * MB, OFF_U0 = 154 * MB, OFF_MEMN = 186 * MB;
constexpr size_t OFF_MERGED = 0 * MB, OFF_HB = 32 * MB, OFF_QC = 72 * MB, OFF_OC = 90 * MB, OFF_OSB = 154 * MB, OFF_ODSA = 170 * MB, OFF_HDN = 64 * MB;
constexpr size_t OFF_WT1 = 192 * MB, OFF_WTSB = 202 * MB, OFF_WTDSA = 203 * MB, OFF_WTOUT = 204 * MB, OFF_WTCQ = 206 * MB, OFF_WTCKV = 207 * MB,
                 OFF_WTCO = 209 * MB, OFF_WTUP = 210 * MB, OFF_WTDOWN = 218 * MB, OFF_KMEM = 226 * MB, OFF_VMEMT = 228 * MB,
                 OFF_ROPEC = 230 * MB, OFF_ROPES = 230 * MB + 256 * 1024, OFF_IW = 230 * MB + 512 * 1024, OFF_ROWSS = 231 * MB, OFF_BAR = 232 * MB, WS_END = 233 * MB;
constexpr int N1 = 4992;
constexpr int N1P = 5120;
constexpr int GATE0 = 2944;

struct KParams {
    const float* in[18];
    float* out;
    unsigned char* ws;
    int ph_lo, ph_hi;
};

typedef float f32x2_t __attribute__((ext_vector_type(2))); typedef __bf16 bf16x2_t __attribute__((ext_vector_type(2)));
DEVINL unsigned cvtpk(float lo, float hi) { f32x2_t v = {lo, hi}; bf16x2_t b = __builtin_convertvector(v, bf16x2_t); return __builtin_bit_cast(unsigned, b); }
DEVINL bf16_t f2bf(float f) { return (bf16_t)(cvtpk(f, 0.f) & 0xffffu); }
DEVINL float bf2f(unsigned h) { return __uint_as_float(h << 16); }
DEVINL unsigned pack2(float a, float b) { return cvtpk(a, b); }
DEVINL uint2 pack4(f32x4 v) { return make_uint2(pack2(v[0], v[1]), pack2(v[2], v[3])); }
DEVINL float wave_sum(float v) {
    v += __shfl_xor(v, 32); v += __shfl_xor(v, 16); v += __shfl_xor(v, 8); v += __shfl_xor(v, 4); v += __shfl_xor(v, 2); v += __shfl_xor(v, 1);
    return v;
}
DEVINL int wave_sum_i(int v) {
    v += __shfl_xor(v, 32); v += __shfl_xor(v, 16); v += __shfl_xor(v, 8); v += __shfl_xor(v, 4); v += __shfl_xor(v, 2); v += __shfl_xor(v, 1);
    return v;
}
DEVINL float wave_min(float v) {
    v = fminf(v, __shfl_xor(v, 32)); v = fminf(v, __shfl_xor(v, 16)); v = fminf(v, __shfl_xor(v, 8));
    v = fminf(v, __shfl_xor(v, 4)); v = fminf(v, __shfl_xor(v, 2)); v = fminf(v, __shfl_xor(v, 1));
    return v;
}
DEVINL f32x4 mfma16(bf16x8 a, bf16x8 b, f32x4 c) { return __builtin_amdgcn_mfma_f32_16x16x32_bf16(a, b, c, 0, 0, 0); }
DEVINL float softplus_f(float z) { return fmaxf(z, 0.f) + __logf(1.f + __expf(-fabsf(z))); }
DEVINL unsigned short f2key(float s) {
    _Float16 hf = (_Float16)s;
    unsigned short bits = __builtin_bit_cast(unsigned short, hf);
    return (bits & 0x8000u) ? (unsigned short)(~bits) : (unsigned short)(bits | 0x8000u);
}

DEVINL int perm256(int l) { const int w = l & 255, j = w >> 6, d = w & 63; return (l & ~255) + (d >> 5) * 128 + j * 32 + (d & 31); }
DEVINL void transpose_job(const float* __restrict__ src, int K, int N, int Npad, bf16_t* __restrict__ dst, const float* __restrict__ kscale, float* tile, bool permute = false, int lbase = 0, int first_blk = 0) {
    const int tid = threadIdx.x;
    const int nkt = K / 64, nnt = Npad / 64, ntile = nkt * nnt;
    if ((int)blockIdx.x < first_blk) return;
    const int stride = (int)gridDim.x - first_blk;
    int t = (int)blockIdx.x - first_blk;
    if (t >= ntile) return;
    const int r0 = tid >> 4, c4 = (tid & 15) * 4;
    float4 va, vb; float sa = 1.f, sb = 1.f;
    auto load = [&](int tt) {
        const int tk = tt % nkt, tn = tt / nkt;
        const int k = tk * 64 + r0, n = tn * 64 + c4;
        va = make_float4(0.f, 0.f, 0.f, 0.f); vb = va;
        if (n < N) { va = *(const float4*)(src + (size_t)k * N + n); vb = *(const float4*)(src + (size_t)(k + 32) * N + n); }
        if (kscale) { sa = kscale[k]; sb = kscale[k + 32]; }
    };
    load(t);
    for (; t < ntile; t += stride) {
        const int tk = t % nkt, tn = t / nkt;
        tile[r0 * 65 + c4 + 0] = va.x * sa; tile[r0 * 65 + c4 + 1] = va.y * sa; tile[r0 * 65 + c4 + 2] = va.z * sa; tile[r0 * 65 + c4 + 3] = va.w * sa;
        tile[(r0 + 32) * 65 + c4 + 0] = vb.x * sb; tile[(r0 + 32) * 65 + c4 + 1] = vb.y * sb; tile[(r0 + 32) * 65 + c4 + 2] = vb.z * sb; tile[(r0 + 32) * 65 + c4 + 3] = vb.w * sb;
        __syncthreads();
        if (t + stride < ntile) load(t + stride);
        {
            const int nr = tid >> 3, kc = (tid & 7) * 8;
            const int n = tn * 64 + nr;
            uint4 o;
            o.x = pack2(tile[(kc + 0) * 65 + nr], tile[(kc + 1) * 65 + nr]);
            o.y = pack2(tile[(kc + 2) * 65 + nr], tile[(kc + 3) * 65 + nr]);
            o.z = pack2(tile[(kc + 4) * 65 + nr], tile[(kc + 5) * 65 + nr]);
            o.w = pack2(tile[(kc + 6) * 65 + nr], tile[(kc + 7) * 65 + nr]);
            const int drow = permute ? perm256(lbase + n) : n;
            *(uint4*)(dst + (size_t)drow * K + tk * 64 + kc) = o;
        }
        __syncthreads();
    }
}

DEVINL void rmsnorm_row_bf16(const float* __restrict__ src, const float* __restrict__ g, bf16_t* __restrict__ dst, int lane) {
    float4 v[4];
    float ss = 0.f;
#pragma unroll
    for (int i = 0; i < 4; i++) {
        v[i] = *(const float4*)(src + i * 256 + lane * 4);
        ss += v[i].x * v[i].x + v[i].y * v[i].y + v[i].z * v[i].z + v[i].w * v[i].w;
    }
    ss = wave_sum(ss);
    const float rs = rsqrtf(ss * (1.f / 1024.f) + EPS);
#pragma unroll
    for (int i = 0; i < 4; i++) {
        const float4 g4 = *(const float4*)(g + i * 256 + lane * 4);
        uint2 o = make_uint2(pack2(v[i].x * rs * g4.x, v[i].y * rs * g4.y), pack2(v[i].z * rs * g4.z, v[i].w * rs * g4.w));
        *(uint2*)(dst + i * 256 + lane * 4) = o;
    }
}

DEVINL void phase_prep(const KParams& p, unsigned char* lds) {
    float* tile = (float*)lds;
    unsigned char* ws = p.ws;
    bf16_t* wt1 = (bf16_t*)(ws + OFF_WT1);
    transpose_job(p.in[3], 1024, 2888, 2944, wt1, nullptr, tile, true, 0);
    transpose_job(p.in[6], 1024, 2048, 2176, wt1, nullptr, tile, true, GATE0);
    transpose_job(p.in[4], 512, 1024, 1024, (bf16_t*)(ws + OFF_WTSB), nullptr, tile);
    transpose_job(p.in[5], 512, 1024, 1024, (bf16_t*)(ws + OFF_WTDSA), nullptr, tile);
    transpose_job(p.in[8], 1024, 1024, 1024, (bf16_t*)(ws + OFF_WTOUT), nullptr, tile);
    transpose_job(p.in[11], 1024, 512, 512, (bf16_t*)(ws + OFF_WTCQ), p.in[9], tile);
    transpose_job(p.in[12], 1024, 1024, 1024, (bf16_t*)(ws + OFF_WTCKV), nullptr, tile);
    const int lane = threadIdx.x & 63, wave = threadIdx.x >> 6;
    {
        const int nw = gridDim.x * 8, w0 = blockIdx.x * 8 + wave;
        for (int r = w0; r < 16384 + 2048; r += 4 * nw) {
            float4 v[4][4];
#pragma unroll
            for (int j = 0; j < 4; j++) {
                const int rr = r + j * nw;
                if (rr < 16384 + 2048) {
                    const float* src = (rr < 16384) ? p.in[0] + (size_t)rr * 1024 : p.in[1] + (size_t)(rr - 16384) * 1024;
#pragma unroll
                    for (int i = 0; i < 4; i++) v[j][i] = *(const float4*)(src + i * 256 + lane * 4);
                }
            }
#pragma unroll
            for (int j = 0; j < 4; j++) {
                const int rr = r + j * nw;
                if (rr < 16384 + 2048) {
                    const float* g = (rr < 16384) ? p.in[2] : p.in[10];
                    bf16_t* dst = (rr < 16384) ? (bf16_t*)(ws + OFF_U0) + (size_t)rr * 1024 : (bf16_t*)(ws + OFF_MEMN) + (size_t)(rr - 16384) * 1024;
                    float ss = 0.f;
#pragma unroll
                    for (int i = 0; i < 4; i++) ss += v[j][i].x * v[j][i].x + v[j][i].y * v[j][i].y + v[j][i].z * v[j][i].z + v[j][i].w * v[j][i].w;
                    ss = wave_sum(ss);
                    const float rs = rsqrtf(ss * (1.f / 1024.f) + EPS);
#pragma unroll
                    for (int i = 0; i < 4; i++) {
                        const float4 g4 = *(const float4*)(g + i * 256 + lane * 4);
                        *(uint2*)(dst + i * 256 + lane * 4) = make_uint2(pack2(v[j][i].x * rs * g4.x, v[j][i].y * rs * g4.y), pack2(v[j][i].z * rs * g4.z, v[j][i].w * rs * g4.w));
                    }
                }
            }
        }
    }
    float* cosT = (float*)(ws + OFF_ROPEC);
    float* sinT = (float*)(ws + OFF_ROPES);
    float* rowss = (float*)(ws + OFF_ROWSS);
    for (int i = blockIdx.x * NTHREADS + threadIdx.x; i < 65536; i += gridDim.x * NTHREADS) {
        const int pos = i >> 5, fi = i & 31;
        const float inv = exp2f(-(float)fi * 0.41524101186092029f);
        const float ang = (float)pos * inv;
        const double rev = (double)ang * 0.15915494309189535;
        const float fr = (float)(rev - floor(rev));
        cosT[i] = __builtin_amdgcn_cosf(fr);
        sinT[i] = __builtin_amdgcn_sinf(fr);
        if (i < 49152) rowss[i] = 0.f;
    }
}

namespace pg8 {
#define PG8_LAS __attribute__((address_space(3)))
typedef unsigned short bf16_t;
typedef short bf16x8 __attribute__((ext_vector_type(8)));
typedef float f32x4 __attribute__((ext_vector_type(4)));
typedef unsigned u32x4 __attribute__((ext_vector_type(4)));
constexpr int BM = 256, BK = 64, HALF = 128, HTB = HALF * BK * 2  , STAGE_BYTES = 8 * HTB, NXCD = 8, WGM = 8;

__host__ __device__ __forceinline__ int lds_byte(int r, int c) { const int st = (r >> 4) * 2 + (c >> 5), rr = r & 15, cc = c & 31, ob = rr * 64 + cc * 2; return st * 1024 + (ob ^ (((ob >> 9) & 1) << 5)); }
__host__ __device__ __forceinline__ void stage_rc(int b, int& R, int& C) { const int st = b / 1024, sb = b % 1024, swz = sb ^ (((sb >> 9) & 1) << 5); R = (st >> 1) * 16 + swz / 64; C = (st & 1) * 32 + (swz % 64) / 2; }
__host__ __device__ __forceinline__ int perm32(int rho) { const int n = rho >> 4, i = rho & 15; return 8 * (i >> 2) + 4 * n + (i & 3); }

struct Unit { int pm, pn; };
struct Gemm { const bf16_t* A; const bf16_t* Bt; int M, N, K; };

struct StaticOrder {
    int nM, nN, nwg, G, c;
    __host__ __device__ void init(int M, int N, int G_, int c_) { nM = M / BM; nN = N / BM; nwg = nM * nN; G = G_; c = c_; }
    __host__ __device__ bool next(int i, Unit& u) const {
        const long L = (long)i * G + c; if (L >= nwg) return false;
        int wgid = (int)L; { const int q = nwg / NXCD, r = nwg % NXCD, xcd = wgid % NXCD, off = wgid / NXCD; wgid = (xcd < r ? xcd * (q + 1) : r * (q + 1) + (xcd - r) * q) + off; }
        const int nig = WGM * nN, gid = wgid / nig, fm = gid * WGM, gsz = (nM - fm) < WGM ? (nM - fm) : WGM;
        u.pm = fm + ((wgid % nig) % gsz); u.pn = (wgid % nig) / gsz; return true;
    }
    __device__ __forceinline__ void a_ready(const Unit&) const {}
    __device__ __forceinline__ void done(const Unit&) const {}
};
template <class Epi, class Sched, bool ALIGN_EPI = false, bool SP2 = false>
__device__ __forceinline__ void gemm_phase(PG8_LAS unsigned char* lds, const Gemm g, const Sched& S, const Epi& E) {
    const int tid = threadIdx.x, wid = __builtin_amdgcn_readfirstlane(tid >> 6), lane = tid & 63, wr = wid >> 2, wc = wid & 3, fr = lane & 15, fq = lane >> 4;
    const int K = g.K, nt = K / BK;
    unsigned voffA[2], voffB[2];
#pragma unroll
    for (int i = 0; i < 2; ++i) { int R, C; stage_rc(tid * 16 + i * 8192, R, C); const int Rb = Epi::PERM ? ((R & ~31) + perm32(R & 31)) : R;
        voffA[i] = (unsigned)(R * K + C) * 2u; voffB[i] = (unsigned)(Rb * K + C) * 2u; }
    const size_t kstep = (size_t)(BK * 2);
    const size_t hstep = (size_t)HALF * K * 2;
    const size_t tstep = 2 * hstep;
    const unsigned ldsw = (unsigned)wid * 1024u;
    const int aoff = lds_byte(wr * 64 + fr, fq * 8), boff = lds_byte(wc * 32 + fr, fq * 8);
#define PG8_SA(b, h) (((b) * 2 + (h)) * HTB)
#define PG8_SB(b, h) ((4 + (b) * 2 + (h)) * HTB)
#define PG8_STAGE(bufoff, gbase, voff) do { _Pragma("unroll") for (int _i = 0; _i < 2; ++_i) \
        __builtin_amdgcn_global_load_lds((const unsigned*)((const char*)(gbase) + (voff)[_i]), (PG8_LAS unsigned*)(lds + (bufoff) + ldsw + _i * 8192), 16, 0, 0); } while (0)
#define PG8_LDA(dst, b, h) do { _Pragma("unroll") for (int m = 0; m < 4; ++m) _Pragma("unroll") for (int k = 0; k < 2; ++k) dst[m][k] = *(const PG8_LAS bf16x8*)(lds + PG8_SA(b, h) + aoff + m * 2048 + k * 1024); } while (0)
#define PG8_LDB(dst, b, h) do { _Pragma("unroll") for (int n = 0; n < 2; ++n) _Pragma("unroll") for (int k = 0; k < 2; ++k) dst[n][k] = *(const PG8_LAS bf16x8*)(lds + PG8_SB(b, h) + boff + n * 2048 + k * 1024); } while (0)
#define PG8_MMA(ai, bj, At, Bt) do { __builtin_amdgcn_s_setprio(1); _Pragma("unroll") for (int m = 0; m < 4; ++m) _Pragma("unroll") for (int n = 0; n < 2; ++n) _Pragma("unroll") for (int k = 0; k < 2; ++k) \
        acc[ai][bj][m][n] = __builtin_amdgcn_mfma_f32_16x16x32_bf16(Bt[n][k], At[m][k], acc[ai][bj][m][n], 0, 0, 0); __builtin_amdgcn_s_setprio(0); } while (0)
#define PG8_WAIT_V(n) asm volatile("s_waitcnt vmcnt(" #n ")" ::: "memory")
#define PG8_WAIT_L(n) asm volatile("s_waitcnt lgkmcnt(" #n ")" ::: "memory")
#define PG8_BAR __builtin_amdgcn_s_barrier()
#define PG8_SCHED __builtin_amdgcn_sched_barrier(0)
    Unit cur, nxt; int ui = 0;
    if (!S.next(0, cur)) return;
    f32x4 acc[2][2][4][2];
#pragma unroll
    for (int a = 0; a < 2; ++a)
#pragma unroll
        for (int b = 0; b < 2; ++b)
#pragma unroll
            for (int m = 0; m < 4; ++m)
#pragma unroll
                for (int n = 0; n < 2; ++n) acc[a][b][m][n] = (f32x4){0.f, 0.f, 0.f, 0.f};
    bf16x8 At[4][2], B0[2][2], B1[2][2];
    const char* cA = (const char*)g.A + (size_t)cur.pm * tstep; const char* cB = (const char*)g.Bt + (size_t)cur.pn * tstep;
    S.a_ready(cur);
    if constexpr (SP2) {
        PG8_STAGE(PG8_SB(0, 0), cB, voffB); PG8_STAGE(PG8_SB(0, 1), cB + hstep, voffB); PG8_STAGE(PG8_SA(0, 0), cA, voffA); PG8_STAGE(PG8_SA(0, 1), cA + hstep, voffA);
        if (wr == 1) PG8_BAR;
        PG8_WAIT_V(2); PG8_BAR;
        PG8_STAGE(PG8_SB(1, 0), cB + kstep, voffB); PG8_STAGE(PG8_SA(1, 0), cA + kstep, voffA); PG8_STAGE(PG8_SB(1, 1), cB + hstep + kstep, voffB);
        PG8_WAIT_V(6); PG8_BAR;
    } else {
        PG8_STAGE(PG8_SB(0, 0), cB, voffB); PG8_STAGE(PG8_SA(0, 0), cA, voffA); PG8_STAGE(PG8_SB(0, 1), cB + hstep, voffB); PG8_STAGE(PG8_SA(0, 1), cA + hstep, voffA);
        if (wr == 1) PG8_BAR;
        PG8_WAIT_V(4); PG8_BAR;
        PG8_STAGE(PG8_SB(1, 0), cB + kstep, voffB); PG8_STAGE(PG8_SA(1, 0), cA + kstep, voffA); PG8_STAGE(PG8_SB(1, 1), cB + hstep + kstep, voffB);
        PG8_WAIT_V(6); PG8_BAR;
    }
    for (;;) {
        const bool has_next = S.next(ui + 1, nxt);
        const char* nA = has_next ? (const char*)g.A + (size_t)nxt.pm * tstep : cA; const char* nB = has_next ? (const char*)g.Bt + (size_t)nxt.pn * tstep : cB;
        for (int t = 0; t < nt; t += 2) {
            const bool last = (t == nt - 2);
            const char* a1 = cA + (size_t)(t + 1) * kstep;
            const char* a2 = last ? nA : cA + (size_t)(t + 2) * kstep; const char* b2 = last ? nB : cB + (size_t)(t + 2) * kstep;
            const char* a3 = a2 + kstep; const char* b3 = b2 + kstep;
            if (last && has_next) S.a_ready(nxt);
            if constexpr (SP2) {
            PG8_LDB(B0, 0, 0); PG8_LDB(B1, 0, 1); PG8_SCHED; PG8_LDA(At, 0, 0); PG8_STAGE(PG8_SA(1, 1), a1 + hstep, voffA);
            PG8_WAIT_V(8); PG8_WAIT_L(0); PG8_BAR; PG8_MMA(0, 0, At, B0); PG8_MMA(0, 1, At, B1); PG8_BAR; PG8_SCHED;
            PG8_LDA(At, 0, 1); PG8_STAGE(PG8_SB(0, 0), b2, voffB); PG8_STAGE(PG8_SB(0, 1), b2 + hstep, voffB); PG8_STAGE(PG8_SA(0, 0), a2, voffA);
            PG8_WAIT_V(8); PG8_WAIT_L(0); PG8_BAR; PG8_MMA(1, 0, At, B0); PG8_MMA(1, 1, At, B1); PG8_BAR; PG8_SCHED;
            PG8_LDB(B0, 1, 0); PG8_LDB(B1, 1, 1); PG8_SCHED; PG8_LDA(At, 1, 0); PG8_STAGE(PG8_SA(0, 1), a2 + hstep, voffA);
            PG8_WAIT_V(8); PG8_WAIT_L(0); PG8_BAR; PG8_MMA(0, 0, At, B0); PG8_MMA(0, 1, At, B1); PG8_BAR; PG8_SCHED;
            PG8_LDA(At, 1, 1); PG8_STAGE(PG8_SB(1, 0), b3, voffB); PG8_STAGE(PG8_SB(1, 1), b3 + hstep, voffB); PG8_STAGE(PG8_SA(1, 0), a3, voffA);
            PG8_WAIT_V(8); PG8_WAIT_L(0); PG8_BAR; PG8_MMA(1, 0, At, B0); PG8_MMA(1, 1, At, B1); PG8_BAR; PG8_SCHED;
            } else {
            PG8_LDB(B0, 0, 0); PG8_SCHED; PG8_LDA(At, 0, 0); PG8_STAGE(PG8_SA(1, 1), a1 + hstep, voffA);
            PG8_WAIT_L(8); PG8_BAR; PG8_WAIT_L(0); PG8_MMA(0, 0, At, B0); PG8_BAR; PG8_SCHED;
            PG8_LDB(B1, 0, 1); PG8_STAGE(PG8_SB(0, 0), b2, voffB);
            PG8_BAR; PG8_WAIT_L(0); PG8_MMA(0, 1, At, B1); PG8_BAR;
            PG8_LDA(At, 0, 1); PG8_STAGE(PG8_SA(0, 0), a2, voffA);
            PG8_BAR; PG8_WAIT_L(0); PG8_MMA(1, 0, At, B0); PG8_BAR; PG8_SCHED;
            PG8_STAGE(PG8_SB(0, 1), b2 + hstep, voffB);
            PG8_WAIT_V(6); PG8_BAR; PG8_MMA(1, 1, At, B1); PG8_BAR;
            PG8_LDB(B0, 1, 0); PG8_SCHED; PG8_LDA(At, 1, 0); PG8_STAGE(PG8_SA(0, 1), a2 + hstep, voffA);
            PG8_WAIT_L(8); PG8_BAR; PG8_WAIT_L(0); PG8_MMA(0, 0, At, B0); PG8_BAR; PG8_SCHED;
            PG8_LDB(B1, 1, 1); PG8_STAGE(PG8_SB(1, 0), b3, voffB);
            PG8_BAR; PG8_WAIT_L(0); PG8_MMA(0, 1, At, B1); PG8_BAR;
            PG8_LDA(At, 1, 1); PG8_STAGE(PG8_SA(1, 0), a3, voffA);
            PG8_BAR; PG8_WAIT_L(0); PG8_MMA(1, 0, At, B0); PG8_BAR; PG8_SCHED;
            PG8_STAGE(PG8_SB(1, 1), b3 + hstep, voffB);
            PG8_WAIT_V(6); PG8_BAR; PG8_MMA(1, 1, At, B1); PG8_BAR;
            }
        }
        if constexpr (ALIGN_EPI) { if (wr == 0) PG8_BAR; }
        if constexpr (!Epi::AFTER_DRAIN) { E(acc, cur, wr, wc, fr, fq); S.done(cur); }
        if (!has_next) break;
#pragma unroll
        for (int a = 0; a < 2; ++a)
#pragma unroll
            for (int b = 0; b < 2; ++b)
#pragma unroll
                for (int m = 0; m < 4; ++m)
#pragma unroll
                    for (int n = 0; n < 2; ++n) acc[a][b][m][n] = (f32x4){0.f, 0.f, 0.f, 0.f};
        cur = nxt; cA = nA; cB = nB; ++ui;
        if constexpr (ALIGN_EPI) { if (wr == 1) PG8_BAR; }
    }
    PG8_WAIT_V(0);
    if constexpr (!ALIGN_EPI) { if (wr == 0) PG8_BAR; }
    PG8_BAR;
    if constexpr (Epi::AFTER_DRAIN) { E.fused(acc, cur, wr, wc, fr, fq, lds, wid, lane); S.done(cur); }
#undef PG8_SA
#undef PG8_SB
#undef PG8_STAGE
#undef PG8_LDA
#undef PG8_LDB
#undef PG8_MMA
#undef PG8_WAIT_V
#undef PG8_WAIT_L
#undef PG8_BAR
#undef PG8_SCHED
}
}
#define XB_TMO      128
#define XB_XCNT(j)  (256  + 64 * (j))
#define XB_XSUB(j)  (1280 + 64 * (j))
#define XB_XGEN(j)  (2304 + 64 * (j))
#define XB_TOP      3328
#define XB_TOPGEN   3392
#define XCD_BAR_WORDS 3456
#define XB_SPIN_CAP (1u << 18)
#define LAS __attribute__((address_space(3)))

__device__ __forceinline__ unsigned xb_ld(unsigned* p)              { return __hip_atomic_load(p, __ATOMIC_RELAXED, __HIP_MEMORY_SCOPE_AGENT); }
__device__ __forceinline__ unsigned xb_add(unsigned* p, unsigned v) { return __hip_atomic_fetch_add(p, v, __ATOMIC_RELAXED, __HIP_MEMORY_SCOPE_AGENT); }
__device__ __forceinline__ unsigned xb_xcc_id() { return (unsigned)__builtin_amdgcn_s_getreg((3 << 11) | 20) & 0xFu; }
#define XB_SPIN(cond, bar) do { unsigned _sp = 0; while (cond) { __builtin_amdgcn_s_sleep(1); \
    if ((++_sp & 255u) == 0u) { if (xb_ld(&(bar)[XB_TMO])) break; if (_sp > XB_SPIN_CAP) { atomicAdd(&(bar)[XB_TMO], 1u); break; } } } } while (0)

struct XcdBarrier {
    unsigned* bar; unsigned x;
    volatile LAS unsigned* st;
};

__device__ __forceinline__ XcdBarrier xcd_barrier_post(unsigned* bar, volatile LAS unsigned* st) {
    XcdBarrier b; b.bar = bar; b.x = xb_xcc_id(); b.st = st;
    if (threadIdx.x == 0) (void)xb_add(&bar[XB_XCNT(b.x)], 1u);
    return b;
}
__device__ __forceinline__ void xcd_barrier_complete(unsigned* bar, unsigned x, unsigned& nloc, unsigned& nx) {
    const unsigned G = gridDim.x * gridDim.y * gridDim.z;
    unsigned sum, cnt, mine, sp = 0u;
    for (;;) {
        sum = 0u; cnt = 0u; mine = 0u;
#pragma unroll
        for (unsigned j = 0; j < 16; ++j) { const unsigned c = xb_ld(&bar[XB_XCNT(j)]); sum += c; cnt += (c > 0u) ? 1u : 0u; mine = (j == x) ? c : mine; }
        if (sum == G) break;
        __builtin_amdgcn_s_sleep(1);
        if ((++sp & 255u) == 0u) { if (xb_ld(&bar[XB_TMO])) break; if (sp > XB_SPIN_CAP) { atomicAdd(&bar[XB_TMO], 1u); break; } }
    }
    nloc = mine > 0u ? mine : 1u; nx = cnt > 0u ? cnt : 1u;
}

__device__ __forceinline__ void xcd_barrier(const XcdBarrier& b) {
    asm volatile("s_waitcnt vmcnt(0)" ::: "memory");
    __syncthreads();
    if (threadIdx.x == 0) {
        unsigned* bar = b.bar;
        __builtin_amdgcn_s_waitcnt(0);
        unsigned nloc = b.st[0], nx = b.st[1];
        if (nloc == 0u) { xcd_barrier_complete(bar, b.x, nloc, nx); b.st[0] = nloc; b.st[1] = nx; }
        const unsigned old = xb_add(&bar[XB_XSUB(b.x)], 1u);
        const unsigned gen = old / nloc;
        if (old + 1u == (gen + 1u) * nloc) {
            __builtin_amdgcn_fence(__ATOMIC_RELEASE, "agent");
            asm volatile("s_waitcnt vmcnt(0)" ::: "memory");
            const unsigned og = xb_add(&bar[XB_TOP], 1u);
            const unsigned tg = og / nx;
            if (og + 1u == (tg + 1u) * nx) xb_add(&bar[XB_TOPGEN], 1u);
            else XB_SPIN(xb_ld(&bar[XB_TOPGEN]) == tg, bar);
            __builtin_amdgcn_fence(__ATOMIC_ACQUIRE, "agent");
            xb_add(&bar[XB_XGEN(b.x)], 1u);
            asm volatile("s_waitcnt vmcnt(0)" ::: "memory");
        } else {
            XB_SPIN(xb_ld(&bar[XB_XGEN(b.x)]) == gen, bar);
            __builtin_amdgcn_fence(__ATOMIC_ACQUIRE, "agent");
            asm volatile("s_waitcnt vmcnt(0)" ::: "memory");
        }
    }
    __syncthreads();
}

DEVINL uint4 pack8(f32x4 a, f32x4 b) { return make_uint4(pack2(a[0], a[1]), pack2(a[2], a[3]), pack2(b[0], b[1]), pack2(b[2], b[3])); }
typedef const f32x4 (&AccRef)[2][2][4][2];

struct EpiInproj {
    static constexpr bool PERM = true, AFTER_DRAIN = false;
    bf16_t *sbq, *sbk, *sbvT, *dq, *dk, *dvT, *iq, *ik, *gates; float* iw; const float *cosT, *sinT, *bgate;
    DEVINL void operator()(AccRef acc, const pg8::Unit& u, int wr, int wc, int fr, int fq) const {
        const int cb = u.pn * 256 + wc * 64;
        if (cb >= N1) return;
        float4 bb[2][2];
        if (cb >= GATE0) {
#pragma unroll
            for (int bj = 0; bj < 2; bj++) { bb[bj][0] = *(const float4*)(bgate + cb - GATE0 + 32 * bj + 8 * fq); bb[bj][1] = *(const float4*)(bgate + cb - GATE0 + 32 * bj + 8 * fq + 4); }
        }
        if (cb >= 1536 && cb < 2880 && !(cb >= 2176 && cb < 2304)) {
            bf16_t* dst0; float sc = 1.f; int ld;
            if (cb < 2048) { dst0 = dq + (cb - 1536); sc = 0.18033688011112042f; ld = 512; }
            else if (cb < 2176) { dst0 = dk + (cb - 2048); ld = 128; }
            else if (cb < 2816) { dst0 = iq + (cb - 2304); sc = 0.125f; ld = 512; }
            else { dst0 = ik; ld = 64; }
            const int rowb = u.pm * 256 + wr * 64 + fr;
#pragma unroll
            for (int ai = 0; ai < 2; ai++)
#pragma unroll
                for (int mh = 0; mh < 2; mh++) {
                    float4 cs[2][2][2];
#pragma unroll
                    for (int mm = 0; mm < 2; mm++)
#pragma unroll
                        for (int n = 0; n < 2; n++) {
                            const int pos = (rowb + ai * 128 + (mh * 2 + mm) * 16) & 2047;
                            cs[mm][n][0] = *(const float4*)(cosT + pos * 32 + 8 * fq + 4 * n);
                            cs[mm][n][1] = *(const float4*)(sinT + pos * 32 + 8 * fq + 4 * n);
                        }
#pragma unroll
                    for (int mm = 0; mm < 2; mm++) {
                        const int m = mh * 2 + mm;
                        bf16_t* dst = dst0 + (size_t)(rowb + ai * 128 + m * 16) * ld;
                        f32x4 o1[2], o2[2];
#pragma unroll
                        for (int n = 0; n < 2; n++) {
                            const float4 c4 = cs[mm][n][0], s4 = cs[mm][n][1];
                            const f32x4 x1 = acc[ai][0][m][n], x2 = acc[ai][1][m][n];
                            o1[n][0] = (x1[0] * c4.x - x2[0] * s4.x) * sc; o2[n][0] = (x2[0] * c4.x + x1[0] * s4.x) * sc;
                            o1[n][1] = (x1[1] * c4.y - x2[1] * s4.y) * sc; o2[n][1] = (x2[1] * c4.y + x1[1] * s4.y) * sc;
                            o1[n][2] = (x1[2] * c4.z - x2[2] * s4.z) * sc; o2[n][2] = (x2[2] * c4.z + x1[2] * s4.z) * sc;
                            o1[n][3] = (x1[3] * c4.w - x2[3] * s4.w) * sc; o2[n][3] = (x2[3] * c4.w + x1[3] * s4.w) * sc;
                        }
                        *(uint4*)(dst + 8 * fq) = pack8(o1[0], o1[1]);
                        *(uint4*)(dst + 32 + 8 * fq) = pack8(o2[0], o2[1]);
                    }
                }
            return;
        }
#pragma unroll
        for (int ai = 0; ai < 2; ai++)
#pragma unroll
            for (int m = 0; m < 4; m++) {
                const int row = u.pm * 256 + ai * 128 + wr * 64 + m * 16 + fr;
                const int pos = row & 2047, b = row >> 11;
                if (cb >= GATE0) {
#pragma unroll
                    for (int bj = 0; bj < 2; bj++) {
                        const int col = cb - GATE0 + 32 * bj + 8 * fq;
                        const float4 b0 = bb[bj][0], b1 = bb[bj][1];
                        f32x4 v0 = acc[ai][bj][m][0], v1 = acc[ai][bj][m][1];
                        v0[0] = __builtin_amdgcn_rcpf(1.f + __expf(-(v0[0] + b0.x))); v0[1] = __builtin_amdgcn_rcpf(1.f + __expf(-(v0[1] + b0.y)));
                        v0[2] = __builtin_amdgcn_rcpf(1.f + __expf(-(v0[2] + b0.z))); v0[3] = __builtin_amdgcn_rcpf(1.f + __expf(-(v0[3] + b0.w)));
                        v1[0] = __builtin_amdgcn_rcpf(1.f + __expf(-(v1[0] + b1.x))); v1[1] = __builtin_amdgcn_rcpf(1.f + __expf(-(v1[1] + b1.y)));
                        v1[2] = __builtin_amdgcn_rcpf(1.f + __expf(-(v1[2] + b1.z))); v1[3] = __builtin_amdgcn_rcpf(1.f + __expf(-(v1[3] + b1.w)));
                        *(uint4*)(gates + (size_t)row * 2048 + col) = pack8(v0, v1);
                    }
                } else if (cb < 1024) {
                    const float sc = cb < 512 ? 0.18033688011112042f : 1.f;
                    bf16_t* dst = (cb < 512 ? sbq + (size_t)row * 512 + cb : sbk + (size_t)row * 512 + (cb - 512));
#pragma unroll
                    for (int bj = 0; bj < 2; bj++) *(uint4*)(dst + 32 * bj + 8 * fq) = pack8(acc[ai][bj][m][0] * sc, acc[ai][bj][m][1] * sc);
                } else if (cb < 1536 || (cb >= 2176 && cb < 2304)) {
                    bf16_t* dst = (cb < 1536) ? sbvT + ((size_t)((b * 8 + ((cb - 1024) >> 6)) * 64)) * 2048 + pos
                                              : dvT + ((size_t)((b * 2 + ((cb - 2176) >> 6)) * 64)) * 2048 + pos;
#pragma unroll
                    for (int bj = 0; bj < 2; bj++)
#pragma unroll
                        for (int n = 0; n < 2; n++)
#pragma unroll
                            for (int r = 0; r < 4; r++) dst[(size_t)(32 * bj + 8 * fq + 4 * n + r) * 2048] = f2bf(acc[ai][bj][m][n][r]);
                } else if (cb < 2880) {
                    bf16_t* dst; float sc = 1.f;
                    if (cb < 2048) { dst = dq + (size_t)row * 512 + (cb - 1536); sc = 0.18033688011112042f; }
                    else if (cb < 2176) { dst = dk + (size_t)row * 128 + (cb - 2048); }
                    else if (cb < 2816) { dst = iq + (size_t)row * 512 + (cb - 2304); sc = 0.125f; }
                    else { dst = ik + (size_t)row * 64; }
                    f32x4 o1[2], o2[2];
#pragma unroll
                    for (int n = 0; n < 2; n++) {
                        const int i0 = 8 * fq + 4 * n;
                        const float4 c4 = *(const float4*)(cosT + pos * 32 + i0);
                        const float4 s4 = *(const float4*)(sinT + pos * 32 + i0);
                        const f32x4 x1 = acc[ai][0][m][n], x2 = acc[ai][1][m][n];
                        o1[n][0] = (x1[0] * c4.x - x2[0] * s4.x) * sc; o2[n][0] = (x2[0] * c4.x + x1[0] * s4.x) * sc;
                        o1[n][1] = (x1[1] * c4.y - x2[1] * s4.y) * sc; o2[n][1] = (x2[1] * c4.y + x1[1] * s4.y) * sc;
                        o1[n][2] = (x1[2] * c4.z - x2[2] * s4.z) * sc; o2[n][2] = (x2[2] * c4.z + x1[2] * s4.z) * sc;
                        o1[n][3] = (x1[3] * c4.w - x2[3] * s4.w) * sc; o2[n][3] = (x2[3] * c4.w + x1[3] * s4.w) * sc;
                    }
                    *(uint4*)(dst + 8 * fq) = pack8(o1[0], o1[1]);
                    *(uint4*)(dst + 32 + 8 * fq) = pack8(o2[0], o2[1]);
                } else {
                    if (fq == 0) {
                        const f32x4 v0 = acc[ai][0][m][0] * 0.35355339059327373f, v1 = acc[ai][0][m][1] * 0.35355339059327373f;
                        *(float4*)(iw + (size_t)row * 8) = make_float4(v0[0], v0[1], v0[2], v0[3]);
                        *(float4*)(iw + (size_t)row * 8 + 4) = make_float4(v1[0], v1[1], v1[2], v1[3]);
                    }
                }
            }
    }
};

struct EpiMemKV {
    static constexpr bool PERM = true, AFTER_DRAIN = false;
    bf16_t *kmem, *vmemT;
    DEVINL void operator()(AccRef acc, const pg8::Unit& u, int wr, int wc, int fr, int fq) const {
#pragma unroll
        for (int ai = 0; ai < 2; ai++)
#pragma unroll
            for (int m = 0; m < 4; m++) {
                const int row = u.pm * 256 + ai * 128 + wr * 64 + m * 16 + fr;
#pragma unroll
                for (int bj = 0; bj < 2; bj++) {
                    const int col = u.pn * 256 + bj * 128 + wc * 32 + 8 * fq;
                    if (col < 512) {
                        *(uint4*)(kmem + (size_t)row * 512 + col) = pack8(acc[ai][bj][m][0], acc[ai][bj][m][1]);
                    } else {
                        const int b = row >> 8, key = row & 255, h = (col - 512) >> 7, d0 = (col - 512) & 127;
                        bf16_t* dst = vmemT + ((size_t)((b * 4 + h) * 128 + d0)) * 256 + key;
#pragma unroll
                        for (int n = 0; n < 2; n++)
#pragma unroll
                            for (int r = 0; r < 4; r++) dst[(size_t)(4 * n + r) * 256] = f2bf(acc[ai][bj][m][n][r]);
                    }
                }
            }
    }
};

struct EpiMerge {
    static constexpr bool PERM = true, AFTER_DRAIN = false;
    const bf16_t* gates; bf16_t* merged; int accum;
    DEVINL void operator()(AccRef acc, const pg8::Unit& u, int wr, int wc, int fr, int fq) const {
#pragma unroll
        for (int ai = 0; ai < 2; ai++)
#pragma unroll
            for (int m = 0; m < 4; m++) {
                const int row = u.pm * 256 + ai * 128 + wr * 64 + m * 16 + fr;
#pragma unroll
                for (int bj = 0; bj < 2; bj++) {
                    const int col = u.pn * 256 + bj * 128 + wc * 32 + 8 * fq;
                    const uint4 g = *(const uint4*)(gates + (size_t)row * 2048 + col);
                    f32x4 v0 = acc[ai][bj][m][0], v1 = acc[ai][bj][m][1];
                    v0[0] *= bf2f(g.x & 0xffffu); v0[1] *= bf2f(g.x >> 16); v0[2] *= bf2f(g.y & 0xffffu); v0[3] *= bf2f(g.y >> 16);
                    v1[0] *= bf2f(g.z & 0xffffu); v1[1] *= bf2f(g.z >> 16); v1[2] *= bf2f(g.w & 0xffffu); v1[3] *= bf2f(g.w >> 16);
                    bf16_t* dst = merged + (size_t)row * 1024 + col;
                    if (accum) {
                        const uint4 o = *(const uint4*)dst;
                        v0[0] += bf2f(o.x & 0xffffu); v0[1] += bf2f(o.x >> 16); v0[2] += bf2f(o.y & 0xffffu); v0[3] += bf2f(o.y >> 16);
                        v1[0] += bf2f(o.z & 0xffffu); v1[1] += bf2f(o.z >> 16); v1[2] += bf2f(o.w & 0xffffu); v1[3] += bf2f(o.w >> 16);
                    }
                    *(uint4*)dst = pack8(v0, v1);
                }
            }
    }
};

template <bool F32RES>
struct EpiResid {
    static constexpr bool PERM = true, AFTER_DRAIN = false;
    const float* res32; bf16_t* hb; float* rowss;
    DEVINL void operator()(AccRef acc, const pg8::Unit& u, int wr, int wc, int fr, int fq) const {
        const int rowb = u.pm * 256 + wr * 64 + fr, colb = u.pn * 256 + wc * 32 + 8 * fq;
#pragma unroll
        for (int ai = 0; ai < 2; ai++)
#pragma unroll
        for (int mh = 0; mh < 2; mh++) {
            float4 xx[2][2][2]; uint4 oo[2][2];
#pragma unroll
            for (int mm = 0; mm < 2; mm++)
#pragma unroll
                for (int bj = 0; bj < 2; bj++) {
                    const int row = rowb + ai * 128 + (mh * 2 + mm) * 16, col = colb + bj * 128;
                    if (F32RES) { xx[mm][bj][0] = *(const float4*)(res32 + (size_t)row * 1024 + col); xx[mm][bj][1] = *(const float4*)(res32 + (size_t)row * 1024 + col + 4); }
                    else oo[mm][bj] = *(const uint4*)(hb + (size_t)row * 1024 + col);
                }
#pragma unroll
            for (int mm = 0; mm < 2; mm++) {
                const int m = mh * 2 + mm;
                const int row = rowb + ai * 128 + m * 16;
                float ss = 0.f;
#pragma unroll
                for (int bj = 0; bj < 2; bj++) {
                    const int col = colb + bj * 128;
                    f32x4 v0 = acc[ai][bj][m][0], v1 = acc[ai][bj][m][1];
                    if (F32RES) {
                        const float4 x0 = xx[mm][bj][0], x1 = xx[mm][bj][1];
                        v0[0] += x0.x; v0[1] += x0.y; v0[2] += x0.z; v0[3] += x0.w; v1[0] += x1.x; v1[1] += x1.y; v1[2] += x1.z; v1[3] += x1.w;
                    } else {
                        const uint4 o = oo[mm][bj];
                        v0[0] += bf2f(o.x & 0xffffu); v0[1] += bf2f(o.x >> 16); v0[2] += bf2f(o.y & 0xffffu); v0[3] += bf2f(o.y >> 16);
                        v1[0] += bf2f(o.z & 0xffffu); v1[1] += bf2f(o.z >> 16); v1[2] += bf2f(o.w & 0xffffu); v1[3] += bf2f(o.w >> 16);
                    }
                    *(uint4*)(hb + (size_t)row * 1024 + col) = pack8(v0, v1);
                    ss += v0[0] * v0[0] + v0[1] * v0[1] + v0[2] * v0[2] + v0[3] * v0[3] + v1[0] * v1[0] + v1[1] * v1[1] + v1[2] * v1[2] + v1[3] * v1[3];
                }
                ss += __shfl_xor(ss, 16); ss += __shfl_xor(ss, 32);
                if (fq == 0) atomicAdd(rowss + row, ss);
            }
        }
    }
};

struct EpiFinal {
    static constexpr bool PERM = true, AFTER_DRAIN = true;
    const bf16_t* hb; float* out; const float* gfin; float* X; unsigned* cnt;
    DEVINL void operator()(AccRef, const pg8::Unit&, int, int, int, int) const {}
    DEVINL void fused(f32x4 (&acc)[2][2][4][2], const pg8::Unit& u, int wr, int wc, int fr, int fq, __attribute__((address_space(3))) unsigned char* ldsb, int, int) const {
        float* part = (float*)(ldsb + 131072);
        float* rsb = part + 1024;
        const int tid = threadIdx.x;
#pragma unroll
        for (int ai = 0; ai < 2; ai++) {
            uint4 oo[4][2];
#pragma unroll
            for (int m = 0; m < 4; m++)
#pragma unroll
                for (int bj = 0; bj < 2; bj++)
                    oo[m][bj] = *(const uint4*)(hb + (size_t)(u.pm * 256 + ai * 128 + wr * 64 + m * 16 + fr) * 1024 + u.pn * 256 + bj * 128 + wc * 32 + 8 * fq);
#pragma unroll
            for (int m = 0; m < 4; m++) {
                const int rowl = ai * 128 + wr * 64 + m * 16 + fr;
                float ss = 0.f;
#pragma unroll
                for (int bj = 0; bj < 2; bj++) {
                    const uint4 o = oo[m][bj];
                    f32x4& v0 = acc[ai][bj][m][0]; f32x4& v1 = acc[ai][bj][m][1];
                    v0[0] += bf2f(o.x & 0xffffu); v0[1] += bf2f(o.x >> 16); v0[2] += bf2f(o.y & 0xffffu); v0[3] += bf2f(o.y >> 16);
                    v1[0] += bf2f(o.z & 0xffffu); v1[1] += bf2f(o.z >> 16); v1[2] += bf2f(o.w & 0xffffu); v1[3] += bf2f(o.w >> 16);
                    ss += v0[0] * v0[0] + v0[1] * v0[1] + v0[2] * v0[2] + v0[3] * v0[3] + v1[0] * v1[0] + v1[1] * v1[1] + v1[2] * v1[2] + v1[3] * v1[3];
                }
                ss += __shfl_xor(ss, 16); ss += __shfl_xor(ss, 32);
                if (fq == 0) part[wc * 256 + rowl] = ss;
            }
        }
        __syncthreads();
        if (tid < 256) __hip_atomic_store(X + (size_t)(u.pm * 4 + u.pn) * 256 + tid, (part[tid] + part[256 + tid]) + (part[512 + tid] + part[768 + tid]), __ATOMIC_RELAXED, __HIP_MEMORY_SCOPE_AGENT);
        asm volatile("s_waitcnt vmcnt(0)" ::: "memory");
        __syncthreads();
        if (tid == 0) {
            __hip_atomic_fetch_add(cnt + u.pm, 1u, __ATOMIC_RELAXED, __HIP_MEMORY_SCOPE_AGENT);
            unsigned spins = 0;
            while (__hip_atomic_load(cnt + u.pm, __ATOMIC_RELAXED, __HIP_MEMORY_SCOPE_AGENT) < 4u) { __builtin_amdgcn_s_sleep(1); if (++spins > (1u << 22)) break; }
        }
        __syncthreads();
        if (tid < 256) {
            float* xp = X + (size_t)(u.pm * 4) * 256 + tid;
            const float s = (__hip_atomic_load(xp, __ATOMIC_RELAXED, __HIP_MEMORY_SCOPE_AGENT) + __hip_atomic_load(xp + 256, __ATOMIC_RELAXED, __HIP_MEMORY_SCOPE_AGENT)) +
                            (__hip_atomic_load(xp + 512, __ATOMIC_RELAXED, __HIP_MEMORY_SCOPE_AGENT) + __hip_atomic_load(xp + 768, __ATOMIC_RELAXED, __HIP_MEMORY_SCOPE_AGENT));
            rsb[tid] = rsqrtf(s * (1.f / 1024.f) + EPS);
        }
        float4 gg[2][2];
#pragma unroll
        for (int bj = 0; bj < 2; bj++) { gg[bj][0] = *(const float4*)(gfin + u.pn * 256 + bj * 128 + wc * 32 + 8 * fq); gg[bj][1] = *(const float4*)(gfin + u.pn * 256 + bj * 128 + wc * 32 + 8 * fq + 4); }
        __syncthreads();
#pragma unroll
        for (int ai = 0; ai < 2; ai++)
#pragma unroll
            for (int m = 0; m < 4; m++) {
                const int rowl = ai * 128 + wr * 64 + m * 16 + fr;
                const int row = u.pm * 256 + rowl;
                const float rs = rsb[rowl];
#pragma unroll
                for (int bj = 0; bj < 2; bj++) {
                    const int col = u.pn * 256 + bj * 128 + wc * 32 + 8 * fq;
                    const float4 g0 = gg[bj][0], g1 = gg[bj][1];
                    const f32x4 v0 = acc[ai][bj][m][0] * rs, v1 = acc[ai][bj][m][1] * rs;
                    *(float4*)(out + (size_t)row * 1024 + col) = make_float4(v0[0] * g0.x, v0[1] * g0.y, v0[2] * g0.z, v0[3] * g0.w);
                    *(float4*)(out + (size_t)row * 1024 + col + 4) = make_float4(v1[0] * g1.x, v1[1] * g1.y, v1[2] * g1.z, v1[3] * g1.w);
                }
            }
    }
};

struct EpiCq {
    static constexpr bool PERM = true, AFTER_DRAIN = false;
    const float* rowss1; bf16_t* qc;
    DEVINL void operator()(AccRef acc, const pg8::Unit& u, int wr, int wc, int fr, int fq) const {
        float rsv[2][4];
#pragma unroll
        for (int ai = 0; ai < 2; ai++)
#pragma unroll
            for (int m = 0; m < 4; m++) rsv[ai][m] = rowss1[u.pm * 256 + ai * 128 + wr * 64 + m * 16 + fr];
#pragma unroll
        for (int ai = 0; ai < 2; ai++)
#pragma unroll
            for (int m = 0; m < 4; m++) {
                const int row = u.pm * 256 + ai * 128 + wr * 64 + m * 16 + fr;
                const float rs = rsqrtf(rsv[ai][m] * (1.f / 1024.f) + EPS) * 0.12751743074602467f;
#pragma unroll
                for (int bj = 0; bj < 2; bj++)
                    *(uint4*)(qc + (size_t)row * 512 + u.pn * 256 + bj * 128 + wc * 32 + 8 * fq) = pack8(acc[ai][bj][m][0] * rs, acc[ai][bj][m][1] * rs);
            }
    }
};

struct EpiUp {
    static constexpr bool PERM = true, AFTER_DRAIN = false;
    const float* rowss2; bf16_t* hdn;
    DEVINL void operator()(AccRef acc, const pg8::Unit& u, int wr, int wc, int fr, int fq) const {
        float rsv[2][4];
#pragma unroll
        for (int ai = 0; ai < 2; ai++)
#pragma unroll
            for (int m = 0; m < 4; m++) rsv[ai][m] = rowss2[u.pm * 256 + ai * 128 + wr * 64 + m * 16 + fr];
#pragma unroll
        for (int ai = 0; ai < 2; ai++)
#pragma unroll
            for (int m = 0; m < 4; m++) {
                const int row = u.pm * 256 + ai * 128 + wr * 64 + m * 16 + fr;
                const float rs = rsqrtf(rsv[ai][m] * (1.f / 1024.f) + EPS);
#pragma unroll
                for (int bj = 0; bj < 2; bj++) {
                    f32x4 v0 = acc[ai][bj][m][0] * rs, v1 = acc[ai][bj][m][1] * rs;
#pragma unroll
                    for (int r = 0; r < 4; r++) { v0[r] = fmaxf(v0[r], 0.f); v1[r] = fmaxf(v1[r], 0.f); }
                    *(uint4*)(hdn + (size_t)row * 4096 + u.pn * 256 + bj * 128 + wc * 32 + 8 * fq) = pack8(v0 * v0, v1 * v1);
                }
            }
    }
};

constexpr int LDP = 72;
struct MergeOrder {
    pg8::StaticOrder S;
    DEVINL bool next(int i, pg8::Unit& u) const { pg8::Unit t; if (!S.next(i >> 1, t)) return false; u.pm = t.pm + 64 * (i & 1); u.pn = t.pn + 4 * (i & 1); return true; }
    DEVINL void a_ready(const pg8::Unit&) const {}
    DEVINL void done(const pg8::Unit&) const {}
};
struct EpiMerge2 {
    static constexpr bool PERM = true, AFTER_DRAIN = false;
    const bf16_t* gates; bf16_t* merged;
    DEVINL void operator()(AccRef acc, const pg8::Unit& u, int wr, int wc, int fr, int fq) const {
        const int second = u.pm >= 64;
        const int pm = u.pm & 63, pn = u.pn & 3;
        const int rowb = pm * 256 + wr * 64 + fr, colb = pn * 256 + wc * 32 + 8 * fq;
#pragma unroll
        for (int ai = 0; ai < 2; ai++)
#pragma unroll
        for (int mh = 0; mh < 2; mh++) {
            uint4 gg[2][2], oo[2][2];
#pragma unroll
            for (int mm = 0; mm < 2; mm++)
#pragma unroll
                for (int bj = 0; bj < 2; bj++) {
                    const int row = rowb + ai * 128 + (mh * 2 + mm) * 16, col = colb + bj * 128;
                    gg[mm][bj] = *(const uint4*)(gates + (size_t)row * 2048 + second * 1024 + col);
                    if (second) oo[mm][bj] = *(const uint4*)(merged + (size_t)row * 1024 + col);
                }
#pragma unroll
            for (int mm = 0; mm < 2; mm++)
#pragma unroll
                for (int bj = 0; bj < 2; bj++) {
                    const int m = mh * 2 + mm;
                    const int row = rowb + ai * 128 + m * 16, col = colb + bj * 128;
                    const uint4 g = gg[mm][bj];
                    f32x4 v0 = acc[ai][bj][m][0], v1 = acc[ai][bj][m][1];
                    v0[0] *= bf2f(g.x & 0xffffu); v0[1] *= bf2f(g.x >> 16); v0[2] *= bf2f(g.y & 0xffffu); v0[3] *= bf2f(g.y >> 16);
                    v1[0] *= bf2f(g.z & 0xffffu); v1[1] *= bf2f(g.z >> 16); v1[2] *= bf2f(g.w & 0xffffu); v1[3] *= bf2f(g.w >> 16);
                    if (second) {
                        const uint4 o = oo[mm][bj];
                        v0[0] += bf2f(o.x & 0xffffu); v0[1] += bf2f(o.x >> 16); v0[2] += bf2f(o.y & 0xffffu); v0[3] += bf2f(o.y >> 16);
                        v1[0] += bf2f(o.z & 0xffffu); v1[1] += bf2f(o.z >> 16); v1[2] += bf2f(o.w & 0xffffu); v1[3] += bf2f(o.w >> 16);
                    }
                    *(uint4*)(merged + (size_t)row * 1024 + col) = pack8(v0, v1);
                }
        }
    }
};

typedef __attribute__((address_space(3))) unsigned char* lds_ptr_t;
template <class Epi, bool MULTI>
DEVINL void run_gemm(unsigned char* lds, const bf16_t* A, const bf16_t* Bt, int M, int N, int K, const Epi& E, int c_override = -1) {
    pg8::Gemm g{A, Bt, M, N, K};
    pg8::StaticOrder S; S.init(M, N, (int)gridDim.x, c_override >= 0 ? c_override : (int)blockIdx.x);
    pg8::gemm_phase<Epi, pg8::StaticOrder, MULTI, true>((lds_ptr_t)lds, g, S, E);
}

DEVINL void phase_inproj(const KParams& p, unsigned char* lds) {
    unsigned char* ws = p.ws;
    EpiInproj E{(bf16_t*)(ws + OFF_SBQ), (bf16_t*)(ws + OFF_SBK), (bf16_t*)(ws + OFF_SBVT), (bf16_t*)(ws + OFF_DQ), (bf16_t*)(ws + OFF_DK), (bf16_t*)(ws + OFF_DVT),
                (bf16_t*)(ws + OFF_IQ), (bf16_t*)(ws + OFF_IK), (bf16_t*)(ws + OFF_GATES), (float*)(ws + OFF_IW),
                (const float*)(ws + OFF_ROPEC), (const float*)(ws + OFF_ROPES), p.in[7]};
    run_gemm<EpiInproj, true>(lds, (const bf16_t*)(ws + OFF_U0), (const bf16_t*)(ws + OFF_WT1), 16384, N1P, 1024, E);
}

#ifndef REP_A
#define REP_A 1
#endif
#ifndef REP_B
#define REP_B 1
#endif
#ifndef REP_C
#define REP_C 1
#endif
#ifndef REP_SB
#define REP_SB 1
#endif
template <int CTRL> DEVINL float dpp_f(float v) { return __builtin_bit_cast(float, __builtin_amdgcn_update_dpp(0, __builtin_bit_cast(int, v), CTRL, 0xF, 0xF, true)); }
template <int CTRL> DEVINL int dpp_i(int v) { return __builtin_amdgcn_update_dpp(0, v, CTRL, 0xF, 0xF, true); }
DEVINL int wave_sum_i_fast(int v) {
    v += dpp_i<0xB1>(v); v += dpp_i<0x4E>(v); v += dpp_i<0x141>(v); v += dpp_i<0x140>(v);
    { auto r = __builtin_amdgcn_permlane16_swap((unsigned)v, (unsigned)v, false, false); v = (int)(r[0] + r[1]); }
    { auto r = __builtin_amdgcn_permlane32_swap((unsigned)v, (unsigned)v, false, false); v = (int)(r[0] + r[1]); }
    return v;
}
DEVINL float lq_max(float v) {
    { auto r = __builtin_amdgcn_permlane16_swap(__float_as_uint(v), __float_as_uint(v), false, false); v = fmaxf(__uint_as_float(r[0]), __uint_as_float(r[1])); }
    { auto r = __builtin_amdgcn_permlane32_swap(__float_as_uint(v), __float_as_uint(v), false, false); v = fmaxf(__uint_as_float(r[0]), __uint_as_float(r[1])); }
    return v;
}
DEVINL float lq_sum(float v) {
    { auto r = __builtin_amdgcn_permlane16_swap(__float_as_uint(v), __float_as_uint(v), false, false); v = __uint_as_float(r[0]) + __uint_as_float(r[1]); }
    { auto r = __builtin_amdgcn_permlane32_swap(__float_as_uint(v), __float_as_uint(v), false, false); v = __uint_as_float(r[0]) + __uint_as_float(r[1]); }
    return v;
}
#define QUAD_XOR1 0xB1
#define QUAD_XOR2 0x4E
DEVINL int opaque_tid() { int t = threadIdx.x; asm volatile("" : "+v"(t)); return t; }
#define WAVE_LDS_SYNC() do { __builtin_amdgcn_fence(__ATOMIC_RELEASE, "wavefront"); __builtin_amdgcn_wave_barrier(); __builtin_amdgcn_fence(__ATOMIC_ACQUIRE, "wavefront"); } while (0)
DEVINL void sb_unit(const KParams& p, unsigned char* lds, int b, int hp, int qt) {
    unsigned char* ws = p.ws;
    const bf16_t* sbq = (const bf16_t*)(ws + OFF_SBQ); const bf16_t* sbk = (const bf16_t*)(ws + OFF_SBK); const bf16_t* sbvT = (const bf16_t*)(ws + OFF_SBVT);
    bf16_t* osb = (bf16_t*)(ws + OFF_OSB);
    bf16_t* Ks = (bf16_t*)lds;
    bf16_t* Vt = Ks + 2 * 64 * LDP;
    float* Ls = (float*)(lds + 8 * 64 * LDP * 2);
    const int tid = opaque_tid(), lane = tid & 63, wave = __builtin_amdgcn_readfirstlane(tid >> 6), lr = lane & 15, lq = lane >> 4;
    const int hw = wave >> 2, h = 2 * hp + hw;
    const int t0 = qt * 64, tw0 = t0 + (wave & 3) * 16;
    const size_t tokbase = (size_t)b * 2048;
    bf16x8 qf[2];
    qf[0] = *(const bf16x8*)(sbq + (tokbase + tw0 + lr) * 512 + h * 64 + lq * 8);
    qf[1] = *(const bf16x8*)(sbq + (tokbase + tw0 + lr) * 512 + h * 64 + 32 + lq * 8);
    f32x4 oacc[4];
#pragma unroll
    for (int n = 0; n < 4; n++) oacc[n] = f32x4{0.f, 0.f, 0.f, 0.f};
    float carry = 0.f;
    const int srow = lane >> 2, sq = lane & 3;
    const int t_s = tw0 + srow;
    float* Lrow_w = Ls + (wave * 16 + lr) * 68;
    float* Lrow_s = Ls + (wave * 16 + srow) * 68;
    const int cr = tid >> 3, cc = (tid & 7) * 8;
    const bf16_t* kg = sbk + (tokbase + cr) * 512 + 2 * hp * 64 + cc;
    const bf16_t* vg = sbvT + ((size_t)((b * 8 + 2 * hp) * 64 + cr)) * 2048 + cc;
    int jt = qt;
    {
        const uint4 pk = *(const uint4*)(kg + (size_t)jt * 64 * 512), pk2 = *(const uint4*)(kg + (size_t)jt * 64 * 512 + 64);
        const uint4 pv = *(const uint4*)(vg + jt * 64), pv2 = *(const uint4*)(vg + (size_t)64 * 2048 + jt * 64);
        *(uint4*)(Ks + cr * LDP + cc) = pk; *(uint4*)(Ks + (64 + cr) * LDP + cc) = pk2;
        *(uint4*)(Vt + cr * LDP + cc) = pv; *(uint4*)(Vt + (64 + cr) * LDP + cc) = pv2;
    }
    __builtin_amdgcn_s_waitcnt(0x0F70);
    __syncthreads();
    int buf = 0;
    for (; jt >= 0; --jt, buf ^= 1) {
        const int j0 = jt * 64;
        uint4 pk, pv, pk2, pv2;
        if (jt > 0) {
            pk = *(const uint4*)(kg + (size_t)(jt - 1) * 64 * 512); pk2 = *(const uint4*)(kg + (size_t)(jt - 1) * 64 * 512 + 64);
            pv = *(const uint4*)(vg + (jt - 1) * 64); pv2 = *(const uint4*)(vg + (size_t)64 * 2048 + (jt - 1) * 64);
        }
        const bf16_t* Kc = Ks + buf * (4 * 64 * LDP) + hw * 64 * LDP;
        const bf16_t* Vc = Vt + buf * (4 * 64 * LDP) + hw * 64 * LDP;
        if (j0 < tw0 + 16 && __ballot(carry < 64.f) != 0ull) {
            f32x4 lg[4];
#pragma unroll
            for (int n = 0; n < 4; n++) lg[n] = f32x4{0.f, 0.f, 0.f, 0.f};
#pragma unroll
            for (int ks = 0; ks < 2; ks++)
#pragma unroll
                for (int n = 0; n < 4; n++) {
                    const bf16x8 kf = *(const bf16x8*)(Kc + (n * 16 + lr) * LDP + ks * 32 + lq * 8);
                    lg[n] = mfma16(kf, qf[ks], lg[n]);
                }
            const int t_r = tw0 + lr;
            float spv[4][4], tot[4], hi[4];
#pragma unroll
            for (int n = 0; n < 4; n++) {
                float g = 0.f;
#pragma unroll
                for (int r = 0; r < 4; r++) {
                    const float z = lg[n][r];
                    const float s2 = fmaxf(z, 0.f) + __builtin_amdgcn_logf(1.f + __builtin_amdgcn_exp2f(-fabsf(z)));
                    spv[n][r] = (j0 + n * 16 + lq * 4 + r < t_r) ? s2 : 0.f;
                    g += spv[n][r];
                }
                const auto r16 = __builtin_amdgcn_permlane16_swap(__float_as_uint(g), __float_as_uint(g), false, false);
                const float x16 = __uint_as_float((lq & 1) ? r16[0] : r16[1]);
                const auto r32 = __builtin_amdgcn_permlane32_swap(__float_as_uint(g), __float_as_uint(g), false, false);
                const float x32 = __uint_as_float((lq >= 2) ? r32[0] : r32[1]);
                const auto r48 = __builtin_amdgcn_permlane16_swap(__float_as_uint(x32), __float_as_uint(x32), false, false);
                const float x48 = __uint_as_float((lq & 1) ? r48[0] : r48[1]);
                tot[n] = (g + x16) + (x32 + x48);
                hi[n] = ((lq & 1) ? 0.f : x16) + ((lq < 2) ? (x32 + x48) : 0.f);
            }
            float base = carry;
#pragma unroll
            for (int n = 3; n >= 0; n--) {
                float run = base + hi[n];
#pragma unroll
                for (int r = 3; r >= 0; r--) {
                    run += spv[n][r];
                    lg[n][r] = (j0 + n * 16 + lq * 4 + r < t_r) ? __builtin_amdgcn_exp2f(lg[n][r] - run) : 0.f;
                }
                base += tot[n];
            }
            carry = base;
#pragma unroll
            for (int ks = 0; ks < 2; ks++) {
                const uint4 pu = make_uint4(pack2(lg[2 * ks][0], lg[2 * ks][1]), pack2(lg[2 * ks][2], lg[2 * ks][3]),
                                            pack2(lg[2 * ks + 1][0], lg[2 * ks + 1][1]), pack2(lg[2 * ks + 1][2], lg[2 * ks + 1][3]));
                const bf16x8 pf = __builtin_bit_cast(bf16x8, pu);
#pragma unroll
                for (int n = 0; n < 4; n++) {
                    const bf16_t* vrow = Vc + (n * 16 + lr) * LDP + ks * 32 + lq * 4;
                    const uint2 v0 = *(const uint2*)(vrow), v1 = *(const uint2*)(vrow + 16);
                    const bf16x8 vf = __builtin_bit_cast(bf16x8, make_uint4(v0.x, v0.y, v1.x, v1.y));
                    oacc[n] = mfma16(vf, pf, oacc[n]);
                }
            }
        }
        if (jt > 0) {
            bf16_t* Kn = Ks + (buf ^ 1) * (4 * 64 * LDP); bf16_t* Vn = Vt + (buf ^ 1) * (4 * 64 * LDP);
            *(uint4*)(Kn + cr * LDP + cc) = pk; *(uint4*)(Kn + (64 + cr) * LDP + cc) = pk2;
            *(uint4*)(Vn + cr * LDP + cc) = pv; *(uint4*)(Vn + (64 + cr) * LDP + cc) = pv2;
        }
        {
            int* dflag = (int*)(lds + 8 * 64 * LDP * 2) + buf * 8;
            if (lane == 0) dflag[wave] = (__ballot(carry < 64.f) == 0ull) ? 1 : 0;
            __syncthreads();
            const int4 f0 = *(const int4*)dflag, f1 = *(const int4*)(dflag + 4);
            if ((f0.x & f0.y & f0.z & f0.w & f1.x & f1.y & f1.z & f1.w) != 0) break;
        }
    }
#pragma unroll
    for (int n = 0; n < 4; n++)
        *(uint2*)(osb + (tokbase + tw0 + lr) * 512 + h * 64 + n * 16 + lq * 4) = pack4(oacc[n]);
}

DEVINL void dsa_unit(const KParams& p, unsigned char* lds, int b, int qt) {
    unsigned char* ws = p.ws;
    const bf16_t* dq = (const bf16_t*)(ws + OFF_DQ); const bf16_t* dk = (const bf16_t*)(ws + OFF_DK); const bf16_t* dvT = (const bf16_t*)(ws + OFF_DVT);
    const bf16_t* iq = (const bf16_t*)(ws + OFF_IQ); const bf16_t* ik = (const bf16_t*)(ws + OFF_IK); const float* iw = (const float*)(ws + OFF_IW);
    bf16_t* odsa = (bf16_t*)(ws + OFF_ODSA);
    unsigned short* Skey = (unsigned short*)lds;
    unsigned* Sel = (unsigned*)(lds + 131072);
    bf16_t* const KB0 = (bf16_t*)lds;
    bf16_t* const KB1 = (bf16_t*)(lds + 36864);
    const int tid = opaque_tid(), lane = tid & 63, wave = __builtin_amdgcn_readfirstlane(tid >> 6), lr = lane & 15, lq = lane >> 4;
    const int t0 = qt * 32;
    const size_t tokbase = (size_t)b * 2048;

    if (t0 >= 256)
    for (int repa = 0; repa < REP_A; repa++)
#pragma unroll 1
    for (int th = 0; th < 2; th++) {
        bf16x8 iqf[8][2];
        const bf16_t* iqrow = iq + (tokbase + t0 + th * 16 + lr) * 512 + lq * 8;
#pragma unroll
        for (int hh = 0; hh < 8; hh++) {
            iqf[hh][0] = *(const bf16x8*)(iqrow + hh * 64);
            iqf[hh][1] = *(const bf16x8*)(iqrow + hh * 64 + 32);
        }
        float wv[4][8];
#pragma unroll
        for (int r = 0; r < 4; r++) {
            const float4 a = *(const float4*)(iw + (tokbase + t0 + th * 16 + lq * 4 + r) * 8);
            const float4 c = *(const float4*)(iw + (tokbase + t0 + th * 16 + lq * 4 + r) * 8 + 4);
            wv[r][0] = a.x; wv[r][1] = a.y; wv[r][2] = a.z; wv[r][3] = a.w; wv[r][4] = c.x; wv[r][5] = c.y; wv[r][6] = c.z; wv[r][7] = c.w;
        }
        const int nsub = 2 * qt + 1 + th;
        const bf16_t* ikbase = ik + (tokbase + lr) * 64 + lq * 8;
        unsigned short* Srow = Skey + (th * 16 + lq * 4) * 2048 + lr;
        bf16x8 ka0 = bf16x8{0, 0, 0, 0, 0, 0, 0, 0}, ka1 = ka0, kb0 = ka0, kb1 = ka0;
        if (wave < nsub) { ka0 = *(const bf16x8*)(ikbase + (size_t)wave * 1024); ka1 = *(const bf16x8*)(ikbase + (size_t)wave * 1024 + 32); }
        if (wave + 8 < nsub) { kb0 = *(const bf16x8*)(ikbase + (size_t)(wave + 8) * 1024); kb1 = *(const bf16x8*)(ikbase + (size_t)(wave + 8) * 1024 + 32); }
        __builtin_amdgcn_s_waitcnt(0x0F70);
        for (int st = wave; st < nsub; st += 16) {
            const bf16x8 a0 = ka0, a1 = ka1, b0 = kb0, b1 = kb1;
            if (st + 16 < nsub) { ka0 = *(const bf16x8*)(ikbase + (size_t)(st + 16) * 1024); ka1 = *(const bf16x8*)(ikbase + (size_t)(st + 16) * 1024 + 32); }
            if (st + 24 < nsub) { kb0 = *(const bf16x8*)(ikbase + (size_t)(st + 24) * 1024); kb1 = *(const bf16x8*)(ikbase + (size_t)(st + 24) * 1024 + 32); }
            float sa[4] = {0.f, 0.f, 0.f, 0.f}, sb[4] = {0.f, 0.f, 0.f, 0.f};
#pragma unroll
            for (int hh = 0; hh < 8; hh++) {
                f32x4 xa = f32x4{0.f, 0.f, 0.f, 0.f}, xb = f32x4{0.f, 0.f, 0.f, 0.f};
                xa = mfma16(iqf[hh][0], a0, xa);
                xb = mfma16(iqf[hh][0], b0, xb);
                xa = mfma16(iqf[hh][1], a1, xa);
                xb = mfma16(iqf[hh][1], b1, xb);
#pragma unroll
                for (int r = 0; r < 4; r++) { sa[r] += fmaxf(xa[r], 0.f) * wv[r][hh]; sb[r] += fmaxf(xb[r], 0.f) * wv[r][hh]; }
            }
#pragma unroll
            for (int r = 0; r < 4; r++) Srow[r * 2048 + st * 16] = f2key(sa[r]);
            if (st + 8 < nsub) {
#pragma unroll
                for (int r = 0; r < 4; r++) Srow[r * 2048 + (st + 8) * 16] = f2key(sb[r]);
            }
        }
    }
    __syncthreads();

#pragma unroll 1
    for (int rr = 0; rr < 4 * REP_B; rr++) {
        const int tl = wave * 4 + (rr & 3);
        const int t = t0 + tl;
        const int nch = (t >> 6) + 1;
        if (t < 256) {
            const int rem = t - lane * 64;
            const unsigned long long m = rem < 0 ? 0ull : (rem >= 63 ? ~0ull : ((2ull << rem) - 1ull));
            if (lane < 32) { Sel[tl * 65 + lane * 2] = (unsigned)m; Sel[tl * 65 + lane * 2 + 1] = (unsigned)(m >> 32); }
            continue;
        }
        unsigned key[32];
#pragma unroll
        for (int c = 0; c < 32; c++) {
            const int s = c * 64 + lane;
            key[c] = (s <= t) ? (unsigned)Skey[tl * 2048 + s] : 0u;
        }
        unsigned Tc = 1;
        int scut = t;
        if (t >= 256) {
            unsigned* hist = (unsigned*)(lds + 139392) + wave * 256;
            unsigned B1 = 0; int above1 = 0, neq = 0;
#pragma unroll 1
            for (int lvl = 0; lvl < 2; lvl++) {
                *(uint4*)(hist + lane * 4) = make_uint4(0u, 0u, 0u, 0u);
#pragma unroll
                for (int c4 = 0; c4 < 8; c4++)
                    if (c4 * 4 < nch) {
#pragma unroll
                        for (int c = c4 * 4; c < c4 * 4 + 4; c++) {
                            if (lvl == 0) atomicAdd(hist + (key[c] >> 8), 1u);
                            else if ((key[c] >> 8) == B1) atomicAdd(hist + (key[c] & 255u), 1u);
                        }
                    }
                const uint4 hb4 = *(const uint4*)(hist + lane * 4);
                const int sl = (int)(hb4.x + hb4.y + hb4.z + hb4.w);
                int v = sl;
                v += dpp_i<0x111>(v); v += dpp_i<0x112>(v); v += dpp_i<0x114>(v); v += dpp_i<0x118>(v);
                const int r0 = __builtin_amdgcn_readlane(v, 15), r1 = __builtin_amdgcn_readlane(v, 31), r2 = __builtin_amdgcn_readlane(v, 47), r3 = __builtin_amdgcn_readlane(v, 63);
                v += (lq >= 1 ? r0 : 0) + (lq >= 2 ? r1 : 0) + (lq >= 3 ? r2 : 0);
                const int total = r0 + r1 + r2 + r3;
                const int target = (lvl == 0) ? 256 : 256 - above1;
                const int sx = total - v;
                const bool owner = (sx < target) && (sx + sl >= target);
                int bin, abv;
                {
                    const int c3 = sx + (int)hb4.w, c2 = c3 + (int)hb4.z, c1 = c2 + (int)hb4.y;
                    if (c3 >= target) { bin = 3; abv = sx; }
                    else if (c2 >= target) { bin = 2; abv = c3; }
                    else if (c1 >= target) { bin = 1; abv = c2; }
                    else { bin = 0; abv = c1; }
                }
                const int cntb = bin == 3 ? (int)hb4.w : bin == 2 ? (int)hb4.z : bin == 1 ? (int)hb4.y : (int)hb4.x;
                const int src = __ffsll((long long)__ballot(owner)) - 1;
                const int obin = __builtin_amdgcn_readlane(bin, src) + 4 * src;
                const int oabv = __builtin_amdgcn_readlane(abv, src);
                if (lvl == 0) { B1 = (unsigned)obin; above1 = oabv; }
                else { Tc = (B1 << 8) | (unsigned)obin; above1 += oabv; neq = __builtin_amdgcn_readlane(cntb, src); }
            }
            const int need = 256 - above1;
            if (neq != need) {
                int cum = 0;
                bool found = false;
#pragma unroll
                for (int c = 0; c < 32; c++) {
                    const unsigned long long m = __ballot(key[c] == Tc);
                    const int pc = __popcll(m);
                    if (!found && cum + pc >= need) {
                        const int kth = need - cum;
                        const int pre = __popcll(m & ((2ull << lane) - 1ull));
                        const bool me = ((m >> lane) & 1ull) && (pre == kth);
                        const unsigned long long mm = __ballot(me);
                        scut = c * 64 + (__ffsll((long long)mm) - 1);
                        found = true;
                    }
                    cum += pc;
                }
            }
        }
        unsigned mlo = 0u, mhi = 0u;
#pragma unroll
        for (int c4 = 0; c4 < 8; c4++)
            if (c4 * 4 < nch) {
#pragma unroll
                for (int c = c4 * 4; c < c4 * 4 + 4; c++) {
                    const int s = c * 64 + lane;
                    const bool sel = (s <= t) && (key[c] > Tc || (key[c] == Tc && s <= scut));
                    const unsigned long long m = __ballot(sel);
                    if (lane == c) { mlo = (unsigned)m; mhi = (unsigned)(m >> 32); }
                }
            }
        if (lane < 32) { Sel[tl * 65 + lane * 2] = mlo; Sel[tl * 65 + lane * 2 + 1] = mhi; }
    }
    __syncthreads();

    for (int repc = 0; repc < REP_C; repc++) {
        const int hd = wave, g = wave >> 2;
        bf16x8 qf[2][2];
#pragma unroll
        for (int rg = 0; rg < 2; rg++) {
            qf[rg][0] = *(const bf16x8*)(dq + (tokbase + t0 + rg * 16 + lr) * 512 + hd * 64 + lq * 8);
            qf[rg][1] = *(const bf16x8*)(dq + (tokbase + t0 + rg * 16 + lr) * 512 + hd * 64 + 32 + lq * 8);
        }
        f32x4 oacc[2][4];
#pragma unroll
        for (int rg = 0; rg < 2; rg++)
#pragma unroll
            for (int n = 0; n < 4; n++) oacc[rg][n] = f32x4{0.f, 0.f, 0.f, 0.f};
        float m_run[2] = {-1e30f, -1e30f}, l_run[2] = {0.f, 0.f};
        const int ntile = (t0 + 31) / 64 + 1;
        const int tidc = opaque_tid();
        const int gg0 = tidc >> 9, gg1 = (tidc + 512) >> 9;
        const int sr = (tidc >> 3) & 63, scn = (tidc & 7) * 8;
        const bf16_t* kg0 = dk + (tokbase + sr) * 128 + gg0 * 64 + scn;
        const bf16_t* kg1 = dk + (tokbase + sr) * 128 + gg1 * 64 + scn;
        const bf16_t* vg0 = dvT + ((size_t)((b * 2 + gg0) * 64 + sr)) * 2048 + scn;
        const bf16_t* vg1 = dvT + ((size_t)((b * 2 + gg1) * 64 + sr)) * 2048 + scn;
        {
            const uint4 pk0 = *(const uint4*)kg0, pk1 = *(const uint4*)kg1, pv0 = *(const uint4*)vg0, pv1 = *(const uint4*)vg1;
            bf16_t* Vn = KB0 + 2 * 64 * LDP;
            *(uint4*)(KB0 + (gg0 * 64 + sr) * LDP + scn) = pk0;
            *(uint4*)(KB0 + (gg1 * 64 + sr) * LDP + scn) = pk1;
            *(uint4*)(Vn + (gg0 * 64 + sr) * LDP + scn) = pv0;
            *(uint4*)(Vn + (gg1 * 64 + sr) * LDP + scn) = pv1;
        }
        __builtin_amdgcn_s_waitcnt(0x0F70);
        __syncthreads();
        for (int kt = 0; kt < ntile; kt++) {
            const int j0 = kt * 64;
            uint4 pk0, pk1, pv0, pv1;
            if (kt + 1 < ntile) {
                pk0 = *(const uint4*)(kg0 + (size_t)(j0 + 64) * 128); pk1 = *(const uint4*)(kg1 + (size_t)(j0 + 64) * 128);
                pv0 = *(const uint4*)(vg0 + j0 + 64); pv1 = *(const uint4*)(vg1 + j0 + 64);
            }
            const bf16_t* Kc = (kt & 1) ? KB1 : KB0;
            const bf16_t* Vc = Kc + 2 * 64 * LDP;
            f32x4 lg[2][4];
#pragma unroll
            for (int rg = 0; rg < 2; rg++)
#pragma unroll
                for (int n = 0; n < 4; n++) lg[rg][n] = f32x4{0.f, 0.f, 0.f, 0.f};
#pragma unroll
            for (int ks = 0; ks < 2; ks++)
#pragma unroll
                for (int n = 0; n < 4; n++) {
                    const bf16x8 kf = *(const bf16x8*)(Kc + (g * 64 + n * 16 + lr) * LDP + ks * 32 + lq * 8);
                    lg[0][n] = mfma16(kf, qf[0][ks], lg[0][n]);
                    lg[1][n] = mfma16(kf, qf[1][ks], lg[1][n]);
                }
            bf16x8 pf[2][2];
#pragma unroll
            for (int rg = 0; rg < 2; rg++) {
                const unsigned* selrow = Sel + (rg * 16 + lr) * 65 + kt * 2;
                const unsigned w0 = selrow[0], w1 = selrow[1];
                float mx = -2e30f;
#pragma unroll
                for (int n = 0; n < 4; n++) {
                    const int wsh = (int)(((n < 2) ? w0 : w1) >> ((n & 1) * 16 + lq * 4));
#pragma unroll
                    for (int r = 0; r < 4; r++) {
                        const int msk = __builtin_amdgcn_sbfe(wsh, r, 1);
                        lg[rg][n][r] = __int_as_float((__float_as_int(lg[rg][n][r]) & msk) | (__float_as_int(-2e30f) & ~msk));
                        mx = fmaxf(mx, lg[rg][n][r]);
                    }
                }
                mx = lq_max(mx);
                const float m_new = fmaxf(m_run[rg], mx);
                const float alpha = __builtin_amdgcn_exp2f(m_run[rg] - m_new);
                float psum = 0.f;
#pragma unroll
                for (int n = 0; n < 4; n++)
#pragma unroll
                    for (int r = 0; r < 4; r++) { lg[rg][n][r] = __builtin_amdgcn_exp2f(lg[rg][n][r] - m_new); psum += lg[rg][n][r]; }
                psum = lq_sum(psum);
                l_run[rg] = l_run[rg] * alpha + psum;
                m_run[rg] = m_new;
#pragma unroll
                for (int n = 0; n < 4; n++) oacc[rg][n] = oacc[rg][n] * alpha;
#pragma unroll
                for (int ks = 0; ks < 2; ks++) {
                    const uint4 pu = make_uint4(pack2(lg[rg][2 * ks][0], lg[rg][2 * ks][1]), pack2(lg[rg][2 * ks][2], lg[rg][2 * ks][3]),
                                                pack2(lg[rg][2 * ks + 1][0], lg[rg][2 * ks + 1][1]), pack2(lg[rg][2 * ks + 1][2], lg[rg][2 * ks + 1][3]));
                    pf[rg][ks] = __builtin_bit_cast(bf16x8, pu);
                }
            }
#pragma unroll
            for (int ks = 0; ks < 2; ks++)
#pragma unroll
                for (int n = 0; n < 4; n++) {
                    const bf16_t* vrow = Vc + (g * 64 + n * 16 + lr) * LDP + ks * 32 + lq * 4;
                    const uint2 v0 = *(const uint2*)(vrow), v1 = *(const uint2*)(vrow + 16);
                    const bf16x8 vf = __builtin_bit_cast(bf16x8, make_uint4(v0.x, v0.y, v1.x, v1.y));
                    oacc[0][n] = mfma16(vf, pf[0][ks], oacc[0][n]);
                    oacc[1][n] = mfma16(vf, pf[1][ks], oacc[1][n]);
                }
            if (kt + 1 < ntile) {
                bf16_t* Kn = (kt & 1) ? KB0 : KB1;
                bf16_t* Vn = Kn + 2 * 64 * LDP;
                *(uint4*)(Kn + (gg0 * 64 + sr) * LDP + scn) = pk0;
                *(uint4*)(Kn + (gg1 * 64 + sr) * LDP + scn) = pk1;
                *(uint4*)(Vn + (gg0 * 64 + sr) * LDP + scn) = pv0;
                *(uint4*)(Vn + (gg1 * 64 + sr) * LDP + scn) = pv1;
            }
            __syncthreads();
        }
#pragma unroll
        for (int rg = 0; rg < 2; rg++) {
            const float inv = 1.f / l_run[rg];
#pragma unroll
            for (int n = 0; n < 4; n++)
                *(uint2*)(odsa + (tokbase + t0 + rg * 16 + lr) * 512 + hd * 64 + n * 16 + lq * 4) = pack4(oacc[rg][n] * inv);
        }
    }
}

DEVINL void phase_mixers(const KParams& p, unsigned char* lds) {
    const int G = gridDim.x;
    for (int r = 0; r * G < 512; r++) {
        const int idx = r * G + ((r & 1) ? (G - 1 - (int)blockIdx.x) : (int)blockIdx.x);
        if (idx < 512) dsa_unit(p, lds, idx & 7, 63 - (idx >> 3));
    }
    __syncthreads();
    for (int u = blockIdx.x; u < 1024; u += G) {
        const int qt = 31 - (u >> 5), rest = u & 31;
        for (int reps = 0; reps < REP_SB; reps++) sb_unit(p, lds, rest >> 2, rest & 3, qt);
    }
}

DEVINL void phase_merge(const KParams& p, unsigned char* lds) {
    unsigned char* ws = p.ws;
    static_assert(OFF_ODSA == OFF_OSB + 16 * MB && OFF_WTDSA == OFF_WTSB + 1 * MB, "the stacked operands must be contiguous");
    pg8::Gemm g{(const bf16_t*)(ws + OFF_OSB), (const bf16_t*)(ws + OFF_WTSB), 32768, 2048, 512};
    MergeOrder S; S.S.init(16384, 1024, (int)gridDim.x, (int)blockIdx.x);
    EpiMerge2 E{(const bf16_t*)(ws + OFF_GATES), (bf16_t*)(ws + OFF_MERGED)};
    pg8::gemm_phase<EpiMerge2, MergeOrder, true, true>((lds_ptr_t)lds, g, S, E);
}

DEVINL void phase_resid(const KParams& p, unsigned char* lds, const bf16_t* A, int K, const bf16_t* Wt, const float* res32, float* rowss) {
    if (res32) { EpiResid<true> E{res32, (bf16_t*)(p.ws + OFF_HB), rowss}; run_gemm<EpiResid<true>, true>(lds, A, Wt, 16384, 1024, K, E); }
    else { EpiResid<false> E{nullptr, (bf16_t*)(p.ws + OFF_HB), rowss}; run_gemm<EpiResid<false>, true>(lds, A, Wt, 16384, 1024, K, E); }
}

DEVINL void phase_down_final(const KParams& p, unsigned char* lds) {
    unsigned char* ws = p.ws;
    EpiFinal E{(const bf16_t*)(ws + OFF_HB), p.out, p.in[17], (float*)(ws + OFF_BAR + 32768), (unsigned*)(ws + OFF_BAR + 16384)};
    run_gemm<EpiFinal, false>(lds, (const bf16_t*)(ws + OFF_HDN), (const bf16_t*)(ws + OFF_WTDOWN), 16384, 1024, 4096, E);
}

DEVINL void phase_cq(const KParams& p, unsigned char* lds) {
    unsigned char* ws = p.ws;
    EpiCq E{(const float*)(ws + OFF_ROWSS), (bf16_t*)(ws + OFF_QC)};
    run_gemm<EpiCq, true>(lds, (const bf16_t*)(ws + OFF_HB), (const bf16_t*)(ws + OFF_WTCQ), 16384, 512, 1024, E);
    EpiMemKV E2{(bf16_t*)(ws + OFF_KMEM), (bf16_t*)(ws + OFF_VMEMT)};
    const int G = gridDim.x;
    int c = (int)blockIdx.x;
    if (G >= 160) c = (c >= 128) ? c - 128 : (1 << 20);
    run_gemm<EpiMemKV, true>(lds, (const bf16_t*)(ws + OFF_MEMN), (const bf16_t*)(ws + OFF_WTCKV), 2048, 1024, 1024, E2, c);
    const int first = (G >= 192) ? 160 : 0;
    float* tile = (float*)lds;
    transpose_job(p.in[13], 512, 1024, 1024, (bf16_t*)(ws + OFF_WTCO), nullptr, tile, false, 0, first);
    transpose_job(p.in[15], 1024, 4096, 4096, (bf16_t*)(ws + OFF_WTUP), p.in[14], tile, false, 0, first);
    transpose_job(p.in[16], 4096, 1024, 1024, (bf16_t*)(ws + OFF_WTDOWN), nullptr, tile, false, 0, first);
}

DEVINL void cross_unit(const KParams& p, unsigned char* lds, int rt2, int h) {
    unsigned char* ws = p.ws;
    const bf16_t* qc = (const bf16_t*)(ws + OFF_QC); const bf16_t* kmem = (const bf16_t*)(ws + OFF_KMEM); const bf16_t* vmemT = (const bf16_t*)(ws + OFF_VMEMT);
    bf16_t* oc = (bf16_t*)(ws + OFF_OC);
    bf16_t* Kl = (bf16_t*)lds;
    bf16_t* Vl = Kl + 256 * 136;
    const int tid = opaque_tid(), lane = tid & 63, wave = __builtin_amdgcn_readfirstlane(tid >> 6), lr = lane & 15, lq = lane >> 4;
    const int b = (rt2 * 256) >> 11;
    bf16x8 qfa[2][4];
#pragma unroll
    for (int half = 0; half < 2; half++) {
        const bf16_t* qrow = qc + (size_t)(rt2 * 256 + half * 128 + wave * 16 + lr) * 512 + h * 128 + lq * 8;
#pragma unroll
        for (int ks = 0; ks < 4; ks++) qfa[half][ks] = *(const bf16x8*)(qrow + ks * 32);
    }
#pragma unroll
    for (int i = 0; i < 8; i++) {
        const int id = tid + i * 512, r = id >> 4, c = (id & 15) * 8;
        *(uint4*)(Kl + r * 136 + c) = *(const uint4*)(kmem + (size_t)(b * 256 + r) * 512 + h * 128 + c);
    }
#pragma unroll
    for (int i = 0; i < 8; i++) {
        const int id = tid + i * 512, r = id >> 5, c = (id & 31) * 8;
        *(uint4*)(Vl + r * 264 + c) = *(const uint4*)(vmemT + ((size_t)((b * 4 + h) * 128 + r)) * 256 + c);
    }
    __syncthreads();
#pragma unroll
    for (int half = 0; half < 2; half++) {
    const int row0 = rt2 * 256 + half * 128;
    bf16x8 qf[4];
#pragma unroll
    for (int ks = 0; ks < 4; ks++) qf[ks] = qfa[half][ks];
    f32x4 s[16];
#pragma unroll
    for (int n = 0; n < 16; n++) s[n] = f32x4{0.f, 0.f, 0.f, 0.f};
#pragma unroll
    for (int ks = 0; ks < 4; ks++)
#pragma unroll
        for (int n = 0; n < 16; n++) {
            const bf16x8 kf = *(const bf16x8*)(Kl + (n * 16 + lr) * 136 + ks * 32 + lq * 8);
            s[n] = mfma16(kf, qf[ks], s[n]);
            if ((n & 7) == 7) __builtin_amdgcn_sched_barrier(0);
        }
    float mx = -3e38f;
#pragma unroll
    for (int n = 0; n < 16; n++) mx = fmaxf(mx, fmaxf(fmaxf(s[n][0], s[n][1]), fmaxf(s[n][2], s[n][3])));
    mx = lq_max(mx);
    float sum = 0.f;
#pragma unroll
    for (int n = 0; n < 16; n++)
#pragma unroll
        for (int r = 0; r < 4; r++) { s[n][r] = __builtin_amdgcn_exp2f(s[n][r] - mx); sum += s[n][r]; }
    sum = lq_sum(sum);
    f32x4 o[8];
#pragma unroll
    for (int n = 0; n < 8; n++) o[n] = f32x4{0.f, 0.f, 0.f, 0.f};
#pragma unroll
    for (int ks = 0; ks < 8; ks++) {
        const uint4 pu = make_uint4(pack2(s[2 * ks][0], s[2 * ks][1]), pack2(s[2 * ks][2], s[2 * ks][3]),
                                    pack2(s[2 * ks + 1][0], s[2 * ks + 1][1]), pack2(s[2 * ks + 1][2], s[2 * ks + 1][3]));
        const bf16x8 pf = __builtin_bit_cast(bf16x8, pu);
#pragma unroll
        for (int n = 0; n < 8; n++) {
            const bf16_t* vrow = Vl + (n * 16 + lr) * 264 + ks * 32 + lq * 4;
            const uint2 v0 = *(const uint2*)(vrow), v1 = *(const uint2*)(vrow + 16);
            const bf16x8 vf = __builtin_bit_cast(bf16x8, make_uint4(v0.x, v0.y, v1.x, v1.y));
            o[n] = mfma16(vf, pf, o[n]);
        }
        __builtin_amdgcn_sched_barrier(0);
    }
    const float inv = __builtin_amdgcn_rcpf(sum);
#pragma unroll
    for (int n = 0; n < 8; n++)
        *(uint2*)(oc + (size_t)(row0 + wave * 16 + lr) * 512 + h * 128 + n * 16 + lq * 4) = pack4(o[n] * inv);
    }
    __syncthreads();
}

DEVINL void phase_up(const KParams& p, unsigned char* lds) {
    unsigned char* ws = p.ws;
    EpiUp E{(const float*)(ws + OFF_ROWSS) + 16384, (bf16_t*)(ws + OFF_HDN)};
    run_gemm<EpiUp, true>(lds, (const bf16_t*)(ws + OFF_HB), (const bf16_t*)(ws + OFF_WTUP), 16384, 4096, 1024, E);
}

DEVINL void phase_final(const KParams& p) {
    const bf16_t* hb = (const bf16_t*)(p.ws + OFF_HB);
    const float* rowss3 = (const float*)(p.ws + OFF_ROWSS) + 32768;
    const float* g = p.in[17];
    for (int i = blockIdx.x * NTHREADS + threadIdx.x; i < 16384 * 128; i += gridDim.x * NTHREADS) {
        const int row = i >> 7, col = (i & 127) * 8;
        const float rs = rsqrtf(rowss3[row] * (1.f / 1024.f) + EPS);
        const uint4 o = *(const uint4*)(hb + (size_t)row * 1024 + col);
        const float4 g0 = *(const float4*)(g + col), g1 = *(const float4*)(g + col + 4);
        float* dst = p.out + (size_t)row * 1024 + col;
        *(float4*)dst = make_float4(bf2f(o.x & 0xffffu) * rs * g0.x, bf2f(o.x >> 16) * rs * g0.y, bf2f(o.y & 0xffffu) * rs * g0.z, bf2f(o.y >> 16) * rs * g0.w);
        *(float4*)(dst + 4) = make_float4(bf2f(o.z & 0xffffu) * rs * g1.x, bf2f(o.z >> 16) * rs * g1.y, bf2f(o.w & 0xffffu) * rs * g1.z, bf2f(o.w >> 16) * rs * g1.w);
    }
}

__global__ void __launch_bounds__(NTHREADS, 2) mega_fwd(KParams p) {
    extern __shared__ __attribute__((aligned(16))) unsigned char lds[];
    cg::grid_group grid = cg::this_grid();
    unsigned char* ws = p.ws;
    float* rowss = (float*)(ws + OFF_ROWSS);
    if (p.ph_lo > p.ph_hi) grid.sync();
    volatile LAS unsigned* xst = (volatile LAS unsigned*)((lds_ptr_t)lds + LDS_BYTES - 16);
    if (threadIdx.x < 4) xst[threadIdx.x] = 0u;
    __syncthreads();
    XcdBarrier xb = xcd_barrier_post((unsigned*)(ws + OFF_BAR), xst);
#ifndef PROBE_DUP
#define PROBE_DUP -1
#endif
#define RUN_PHASE(k, body) if (p.ph_lo <= (k) && (k) < p.ph_hi) { body; if ((k) == PROBE_DUP) { xcd_barrier(xb); body; } if ((k) + 1 < p.ph_hi) xcd_barrier(xb); }
    RUN_PHASE(0, phase_prep(p, lds))
    RUN_PHASE(1, phase_inproj(p, lds))
    RUN_PHASE(2, phase_mixers(p, lds))
    RUN_PHASE(3, phase_merge(p, lds))
    RUN_PHASE(4, phase_resid(p, lds, (const bf16_t*)(ws + OFF_MERGED), 1024, (const bf16_t*)(ws + OFF_WTOUT), p.in[0], rowss))
    RUN_PHASE(5, phase_cq(p, lds))
    RUN_PHASE(6, for (int u = blockIdx.x; u < 256; u += gridDim.x) cross_unit(p, lds, u >> 2, u & 3))
    RUN_PHASE(7, phase_resid(p, lds, (const bf16_t*)(ws + OFF_OC), 512, (const bf16_t*)(ws + OFF_WTCO), nullptr, rowss + 16384))
    RUN_PHASE(8, phase_up(p, lds))
    if (gridDim.x == 256) {
        if (p.ph_lo <= 9 && 9 < p.ph_hi) phase_down_final(p, lds);
    } else {
        RUN_PHASE(9, phase_resid(p, lds, (const bf16_t*)(ws + OFF_HDN), 4096, (const bf16_t*)(ws + OFF_WTDOWN), nullptr, rowss + 32768))
        RUN_PHASE(10, phase_final(p))
    }
}

extern "C" void kernel_launch(void* const* d_in, const int* in_sizes, int n_in, void* d_out, int out_size, void* d_ws, size_t ws_size, hipStream_t stream) {
    static int grid = 0;
    if (grid == 0) {
        if (n_in != 18 || out_size != 16384 * 1024 || ws_size < WS_END) {
            fprintf(stderr, "kernel_launch: unexpected problem (n_in %d, out %d, ws %zu, need %zu)\n", n_in, out_size, ws_size, (size_t)WS_END);
            grid = -1; return;
        }
        int dev = 0, cus = 0, per_cu = 0;
        hipGetDevice(&dev);
        hipDeviceGetAttribute(&cus, hipDeviceAttributeMultiprocessorCount, dev);
        if (hipFuncSetAttribute((const void*)mega_fwd, hipFuncAttributeMaxDynamicSharedMemorySize, LDS_BYTES) != hipSuccess) {
            fprintf(stderr, "kernel_launch: hipFuncSetAttribute failed\n"); grid = -1; return;
        }
        if (hipOccupancyMaxActiveBlocksPerMultiprocessor(&per_cu, (const void*)mega_fwd, NTHREADS, LDS_BYTES) != hipSuccess || per_cu < 1) {
            fprintf(stderr, "kernel_launch: occupancy query says %d blocks per CU\n", per_cu);
            per_cu = 1;
        }
        (void)hipGetLastError();
        grid = cus;
    }
    if (grid < 0) return;
    if (hipMemsetAsync((unsigned char*)d_ws + OFF_BAR, 0, 16384 + 256, stream) != hipSuccess) { fprintf(stderr, "kernel_launch: memset of the barrier words failed\n"); return; }
    KParams p{};
    for (int i = 0; i < 18; i++) p.in[i] = (const float*)d_in[i];
    p.out = (float*)d_out;
    p.ws = (unsigned char*)d_ws;
    p.ph_lo = 0; p.ph_hi = 11;
    void* args[] = {&p};
    hipError_t e = hipLaunchCooperativeKernel((const void*)mega_fwd, dim3(grid), dim3(NTHREADS), args, LDS_BYTES, stream);
    if (e != hipSuccess) fprintf(stderr, "kernel_launch: cooperative launch failed: %s (grid %d)\n", hipGetErrorString(e), grid);
}
```

```cpp
#include <hip/hip_runtime.h>
#include <hip/hip_cooperative_groups.h>
#include <cstdio>
#include <cstdint>
namespace cg = cooperative_groups;

#define DEVINL __device__ __forceinline__
typedef unsigned short bf16_t;
typedef short bf16x8 __attribute__((ext_vector_type(8)));
typedef float f32x4 __attribute__((ext_vector_type(4)));

constexpr int NTHREADS = 512;
constexpr int LDS_BYTES = 159744;
constexpr float EPS = 1e-6f;
constexpr size_t MB = 1u << 20;

constexpr size_t OFF_SBQ = 0 * MB, OFF_SBK = 16 * MB, OFF_SBVT = 32 * MB, OFF_DQ = 48 * MB, OFF_DK = 64 * MB, OFF_DVT = 68 * MB,
                 OFF_IQ = 72 * MB, OFF_IK = 88 * MB, OFF_GATES = 90 * MB, OFF_U0 = 154 * MB, OFF_MEMN = 186 * MB;
constexpr size_t OFF_MERGED = 0 * MB, OFF_HB = 32 * MB, OFF_QC = 72 * MB, OFF_OC = 90 * MB, OFF_OSB = 154 * MB, OFF_ODSA = 170 * MB, OFF_HDN = 64 * MB;
constexpr size_t OFF_WT1 = 192 * MB, OFF_WTSB = 202 * MB, OFF_WTDSA = 203 * MB, OFF_WTOUT = 204 * MB, OFF_WTCQ = 206 * MB, OFF_WTCKV = 207 * MB,
                 OFF_WTCO = 209 * MB, OFF_WTUP = 210 * MB, OFF_WTDOWN = 218 * MB, OFF_KMEM = 226 * MB, OFF_VMEMT = 228 * MB,
                 OFF_ROPEC = 230 * MB, OFF_ROPES = 230 * MB + 256 * 1024, OFF_IW = 230 * MB + 512 * 1024, OFF_ROWSS = 231 * MB, OFF_BAR = 232 * MB, WS_END = 233 * MB;
constexpr int N1 = 4992;
constexpr int N1P = 5120;
constexpr int GATE0 = 2944;

struct KParams {
    const float* in[18];
    float* out;
    unsigned char* ws;
    int ph_lo, ph_hi;
};

typedef float f32x2_t __attribute__((ext_vector_type(2))); typedef __bf16 bf16x2_t __attribute__((ext_vector_type(2)));
DEVINL unsigned cvtpk(float lo, float hi) { f32x2_t v = {lo, hi}; bf16x2_t b = __builtin_convertvector(v, bf16x2_t); return __builtin_bit_cast(unsigned, b); }
DEVINL bf16_t f2bf(float f) { return (bf16_t)(cvtpk(f, 0.f) & 0xffffu); }
DEVINL float bf2f(unsigned h) { return __uint_as_float(h << 16); }
DEVINL unsigned pack2(float a, float b) { return cvtpk(a, b); }
DEVINL uint2 pack4(f32x4 v) { return make_uint2(pack2(v[0], v[1]), pack2(v[2], v[3])); }
DEVINL float wave_sum(float v) {
    v += __shfl_xor(v, 32); v += __shfl_xor(v, 16); v += __shfl_xor(v, 8); v += __shfl_xor(v, 4); v += __shfl_xor(v, 2); v += __shfl_xor(v, 1);
    return v;
}
DEVINL int wave_sum_i(int v) {
    v += __shfl_xor(v, 32); v += __shfl_xor(v, 16); v += __shfl_xor(v, 8); v += __shfl_xor(v, 4); v += __shfl_xor(v, 2); v += __shfl_xor(v, 1);
    return v;
}
DEVINL float wave_min(float v) {
    v = fminf(v, __shfl_xor(v, 32)); v = fminf(v, __shfl_xor(v, 16)); v = fminf(v, __shfl_xor(v, 8));
    v = fminf(v, __shfl_xor(v, 4)); v = fminf(v, __shfl_xor(v, 2)); v = fminf(v, __shfl_xor(v, 1));
    return v;
}
DEVINL f32x4 mfma16(bf16x8 a, bf16x8 b, f32x4 c) { return __builtin_amdgcn_mfma_f32_16x16x32_bf16(a, b, c, 0, 0, 0); }
DEVINL float softplus_f(float z) { return fmaxf(z, 0.f) + __logf(1.f + __expf(-fabsf(z))); }
DEVINL unsigned short f2key(float s) {
    _Float16 hf = (_Float16)s;
    unsigned short bits = __builtin_bit_cast(unsigned short, hf);
    return (bits & 0x8000u) ? (unsigned short)(~bits) : (unsigned short)(bits | 0x8000u);
}

DEVINL int perm256(int l) { const int w = l & 255, j = w >> 6, d = w & 63; return (l & ~255) + (d >> 5) * 128 + j * 32 + (d & 31); }
DEVINL void transpose_job(const float* __restrict__ src, int K, int N, int Npad, bf16_t* __restrict__ dst, const float* __restrict__ kscale, float* tile, bool permute = false, int lbase = 0, int first_blk = 0) {
    const int tid = threadIdx.x;
    const int nkt = K / 64, nnt = Npad / 64, ntile = nkt * nnt;
    if ((int)blockIdx.x < first_blk) return;
    const int stride = (int)gridDim.x - first_blk;
    int t = (int)blockIdx.x - first_blk;
    if (t >= ntile) return;
    const int r0 = tid >> 4, c4 = (tid & 15) * 4;
    float4 va, vb; float sa = 1.f, sb = 1.f;
    auto load = [&](int tt) {
        const int tk = tt % nkt, tn = tt / nkt;
        const int k = tk * 64 + r0, n = tn * 64 + c4;
        va = make_float4(0.f, 0.f, 0.f, 0.f); vb = va;
        if (n < N) { va = *(const float4*)(src + (size_t)k * N + n); vb = *(const float4*)(src + (size_t)(k + 32) * N + n); }
        if (kscale) { sa = kscale[k]; sb = kscale[k + 32]; }
    };
    load(t);
    for (; t < ntile; t += stride) {
        const int tk = t % nkt, tn = t / nkt;
        tile[r0 * 65 + c4 + 0] = va.x * sa; tile[r0 * 65 + c4 + 1] = va.y * sa; tile[r0 * 65 + c4 + 2] = va.z * sa; tile[r0 * 65 + c4 + 3] = va.w * sa;
        tile[(r0 + 32) * 65 + c4 + 0] = vb.x * sb; tile[(r0 + 32) * 65 + c4 + 1] = vb.y * sb; tile[(r0 + 32) * 65 + c4 + 2] = vb.z * sb; tile[(r0 + 32) * 65 + c4 + 3] = vb.w * sb;
        __syncthreads();
        if (t + stride < ntile) load(t + stride);
        {
            const int nr = tid >> 3, kc = (tid & 7) * 8;
            const int n = tn * 64 + nr;
            uint4 o;
            o.x = pack2(tile[(kc + 0) * 65 + nr], tile[(kc + 1) * 65 + nr]);
            o.y = pack2(tile[(kc + 2) * 65 + nr], tile[(kc + 3) * 65 + nr]);
            o.z = pack2(tile[(kc + 4) * 65 + nr], tile[(kc + 5) * 65 + nr]);
            o.w = pack2(tile[(kc + 6) * 65 + nr], tile[(kc + 7) * 65 + nr]);
            const int drow = permute ? perm256(lbase + n) : n;
            *(uint4*)(dst + (size_t)drow * K + tk * 64 + kc) = o;
        }
        __syncthreads();
    }
}

DEVINL void rmsnorm_row_bf16(const float* __restrict__ src, const float* __restrict__ g, bf16_t* __restrict__ dst, int lane) {
    float4 v[4];
    float ss = 0.f;
#pragma unroll
    for (int i = 0; i < 4; i++) {
        v[i] = *(const float4*)(src + i * 256 + lane * 4);
        ss += v[i].x * v[i].x + v[i].y * v[i].y + v[i].z * v[i].z + v[i].w * v[i].w;
    }
    ss = wave_sum(ss);
    const float rs = rsqrtf(ss * (1.f / 1024.f) + EPS);
#pragma unroll
    for (int i = 0; i < 4; i++) {
        const float4 g4 = *(const float4*)(g + i * 256 + lane * 4);
        uint2 o = make_uint2(pack2(v[i].x * rs * g4.x, v[i].y * rs * g4.y), pack2(v[i].z * rs * g4.z, v[i].w * rs * g4.w));
        *(uint2*)(dst + i * 256 + lane * 4) = o;
    }
}

DEVINL void phase_prep(const KParams& p, unsigned char* lds) {
    float* tile = (float*)lds;
    unsigned char* ws = p.ws;
    bf16_t* wt1 = (bf16_t*)(ws + OFF_WT1);
    transpose_job(p.in[3], 1024, 2888, 2944, wt1, nullptr, tile, true, 0);
    transpose_job(p.in[6], 1024, 2048, 2176, wt1, nullptr, tile, true, GATE0);
    transpose_job(p.in[4], 512, 1024, 1024, (bf16_t*)(ws + OFF_WTSB), nullptr, tile);
    transpose_job(p.in[5], 512, 1024, 1024, (bf16_t*)(ws + OFF_WTDSA), nullptr, tile);
    transpose_job(p.in[8], 1024, 1024, 1024, (bf16_t*)(ws + OFF_WTOUT), nullptr, tile);
    transpose_job(p.in[11], 1024, 512, 512, (bf16_t*)(ws + OFF_WTCQ), p.in[9], tile);
    transpose_job(p.in[12], 1024, 1024, 1024, (bf16_t*)(ws + OFF_WTCKV), nullptr, tile);
    const int lane = threadIdx.x & 63, wave = threadIdx.x >> 6;
    {
        const int nw = gridDim.x * 8, w0 = blockIdx.x * 8 + wave;
        for (int r = w0; r < 16384 + 2048; r += 4 * nw) {
            float4 v[4][4];
#pragma unroll
            for (int j = 0; j < 4; j++) {
                const int rr = r + j * nw;
                if (rr < 16384 + 2048) {
                    const float* src = (rr < 16384) ? p.in[0] + (size_t)rr * 1024 : p.in[1] + (size_t)(rr - 16384) * 1024;
#pragma unroll
                    for (int i = 0; i < 4; i++) v[j][i] = *(const float4*)(src + i * 256 + lane * 4);
                }
            }
#pragma unroll
            for (int j = 0; j < 4; j++) {
                const int rr = r + j * nw;
                if (rr < 16384 + 2048) {
                    const float* g = (rr < 16384) ? p.in[2] : p.in[10];
                    bf16_t* dst = (rr < 16384) ? (bf16_t*)(ws + OFF_U0) + (size_t)rr * 1024 : (bf16_t*)(ws + OFF_MEMN) + (size_t)(rr - 16384) * 1024;
                    float ss = 0.f;
#pragma unroll
                    for (int i = 0; i < 4; i++) ss += v[j][i].x * v[j][i].x + v[j][i].y * v[j][i].y + v[j][i].z * v[j][i].z + v[j][i].w * v[j][i].w;
                    ss = wave_sum(ss);
                    const float rs = rsqrtf(ss * (1.f / 1024.f) + EPS);
#pragma unroll
                    for (int i = 0; i < 4; i++) {
                        const float4 g4 = *(const float4*)(g + i * 256 + lane * 4);
                        *(uint2*)(dst + i * 256 + lane * 4) = make_uint2(pack2(v[j][i].x * rs * g4.x, v[j][i].y * rs * g4.y), pack2(v[j][i].z * rs * g4.z, v[j][i].w * rs * g4.w));
                    }
                }
            }
        }
    }
    float* cosT = (float*)(ws + OFF_ROPEC);
    float* sinT = (float*)(ws + OFF_ROPES);
    float* rowss = (float*)(ws + OFF_ROWSS);
    for (int i = blockIdx.x * NTHREADS + threadIdx.x; i < 65536; i += gridDim.x * NTHREADS) {
        const int pos = i >> 5, fi = i & 31;
        const float inv = exp2f(-(float)fi * 0.41524101186092029f);
        const float ang = (float)pos * inv;
        const double rev = (double)ang * 0.15915494309189535;
        const float fr = (float)(rev - floor(rev));
        cosT[i] = __builtin_amdgcn_cosf(fr);
        sinT[i] = __builtin_amdgcn_sinf(fr);
        if (i < 49152) rowss[i] = 0.f;
    }
}

namespace pg8 {
#define PG8_LAS __attribute__((address_space(3)))
typedef unsigned short bf16_t;
typedef short bf16x8 __attribute__((ext_vector_type(8)));
typedef float f32x4 __attribute__((ext_vector_type(4)));
typedef unsigned u32x4 __attribute__((ext_vector_type(4)));
constexpr int BM = 256, BK = 64, HALF = 128, HTB = HALF * BK * 2  , STAGE_BYTES = 8 * HTB, NXCD = 8, WGM = 8;

__host__ __device__ __forceinline__ int lds_byte(int r, int c) { const int st = (r >> 4) * 2 + (c >> 5), rr = r & 15, cc = c & 31, ob = rr * 64 + cc * 2; return st * 1024 + (ob ^ (((ob >> 9) & 1) << 5)); }
__host__ __device__ __forceinline__ void stage_rc(int b, int& R, int& C) { const int st = b / 1024, sb = b % 1024, swz = sb ^ (((sb >> 9) & 1) << 5); R = (st >> 1) * 16 + swz / 64; C = (st & 1) * 32 + (swz % 64) / 2; }
__host__ __device__ __forceinline__ int perm32(int rho) { const int n = rho >> 4, i = rho & 15; return 8 * (i >> 2) + 4 * n + (i & 3); }

struct Unit { int pm, pn; };
struct Gemm { const bf16_t* A; const bf16_t* Bt; int M, N, K; };

struct StaticOrder {
    int nM, nN, nwg, G, c;
    __host__ __device__ void init(int M, int N, int G_, int c_) { nM = M / BM; nN = N / BM; nwg = nM * nN; G = G_; c = c_; }
    __host__ __device__ bool next(int i, Unit& u) const {
        const long L = (long)i * G + c; if (L >= nwg) return false;
        int wgid = (int)L; { const int q = nwg / NXCD, r = nwg % NXCD, xcd = wgid % NXCD, off = wgid / NXCD; wgid = (xcd < r ? xcd * (q + 1) : r * (q + 1) + (xcd - r) * q) + off; }
        const int nig = WGM * nN, gid = wgid / nig, fm = gid * WGM, gsz = (nM - fm) < WGM ? (nM - fm) : WGM;
        u.pm = fm + ((wgid % nig) % gsz); u.pn = (wgid % nig) / gsz; return true;
    }
    __device__ __forceinline__ void a_ready(const Unit&) const {}
    __device__ __forceinline__ void done(const Unit&) const {}
};
template <class Epi, class Sched, bool ALIGN_EPI = false, bool SP2 = false>
__device__ __forceinline__ void gemm_phase(PG8_LAS unsigned char* lds, const Gemm g, const Sched& S, const Epi& E) {
    const int tid = threadIdx.x, wid = __builtin_amdgcn_readfirstlane(tid >> 6), lane = tid & 63, wr = wid >> 2, wc = wid & 3, fr = lane & 15, fq = lane >> 4;
    const int K = g.K, nt = K / BK;
    unsigned voffA[2], voffB[2];
#pragma unroll
    for (int i = 0; i < 2; ++i) { int R, C; stage_rc(tid * 16 + i * 8192, R, C); const int Rb = Epi::PERM ? ((R & ~31) + perm32(R & 31)) : R;
        voffA[i] = (unsigned)(R * K + C) * 2u; voffB[i] = (unsigned)(Rb * K + C) * 2u; }
    const size_t kstep = (size_t)(BK * 2);
    const size_t hstep = (size_t)HALF * K * 2;
    const size_t tstep = 2 * hstep;
    const unsigned ldsw = (unsigned)wid * 1024u;
    const int aoff = lds_byte(wr * 64 + fr, fq * 8), boff = lds_byte(wc * 32 + fr, fq * 8);
#define PG8_SA(b, h) (((b) * 2 + (h)) * HTB)
#define PG8_SB(b, h) ((4 + (b) * 2 + (h)) * HTB)
#define PG8_STAGE(bufoff, gbase, voff) do { _Pragma("unroll") for (int _i = 0; _i < 2; ++_i) \
        __builtin_amdgcn_global_load_lds((const unsigned*)((const char*)(gbase) + (voff)[_i]), (PG8_LAS unsigned*)(lds + (bufoff) + ldsw + _i * 8192), 16, 0, 0); } while (0)
#define PG8_LDA(dst, b, h) do { _Pragma("unroll") for (int m = 0; m < 4; ++m) _Pragma("unroll") for (int k = 0; k < 2; ++k) dst[m][k] = *(const PG8_LAS bf16x8*)(lds + PG8_SA(b, h) + aoff + m * 2048 + k * 1024); } while (0)
#define PG8_LDB(dst, b, h) do { _Pragma("unroll") for (int n = 0; n < 2; ++n) _Pragma("unroll") for (int k = 0; k < 2; ++k) dst[n][k] = *(const PG8_LAS bf16x8*)(lds + PG8_SB(b, h) + boff + n * 2048 + k * 1024); } while (0)
#define PG8_MMA(ai, bj, At, Bt) do { __builtin_amdgcn_s_setprio(1); _Pragma("unroll") for (int m = 0; m < 4; ++m) _Pragma("unroll") for (int n = 0; n < 2; ++n) _Pragma("unroll") for (int k = 0; k < 2; ++k) \
        acc[ai][bj][m][n] = __builtin_amdgcn_mfma_f32_16x16x32_bf16(Bt[n][k], At[m][k], acc[ai][bj][m][n], 0, 0, 0); __builtin_amdgcn_s_setprio(0); } while (0)
#define PG8_WAIT_V(n) asm volatile("s_waitcnt vmcnt(" #n ")" ::: "memory")
#define PG8_WAIT_L(n) asm volatile("s_waitcnt lgkmcnt(" #n ")" ::: "memory")
#define PG8_BAR __builtin_amdgcn_s_barrier()
#define PG8_SCHED __builtin_amdgcn_sched_barrier(0)
    Unit cur, nxt; int ui = 0;
    if (!S.next(0, cur)) return;
    f32x4 acc[2][2][4][2];
#pragma unroll
    for (int a = 0; a < 2; ++a)
#pragma unroll
        for (int b = 0; b < 2; ++b)
#pragma unroll
            for (int m = 0; m < 4; ++m)
#pragma unroll
                for (int n = 0; n < 2; ++n) acc[a][b][m][n] = (f32x4){0.f, 0.f, 0.f, 0.f};
    bf16x8 At[4][2], B0[2][2], B1[2][2];
    const char* cA = (const char*)g.A + (size_t)cur.pm * tstep; const char* cB = (const char*)g.Bt + (size_t)cur.pn * tstep;
    S.a_ready(cur);
    if constexpr (SP2) {
        PG8_STAGE(PG8_SB(0, 0), cB, voffB); PG8_STAGE(PG8_SB(0, 1), cB + hstep, voffB); PG8_STAGE(PG8_SA(0, 0), cA, voffA); PG8_STAGE(PG8_SA(0, 1), cA + hstep, voffA);
        if (wr == 1) PG8_BAR;
        PG8_WAIT_V(2); PG8_BAR;
        PG8_STAGE(PG8_SB(1, 0), cB + kstep, voffB); PG8_STAGE(PG8_SA(1, 0), cA + kstep, voffA); PG8_STAGE(PG8_SB(1, 1), cB + hstep + kstep, voffB);
        PG8_WAIT_V(6); PG8_BAR;
    } else {
        PG8_STAGE(PG8_SB(0, 0), cB, voffB); PG8_STAGE(PG8_SA(0, 0), cA, voffA); PG8_STAGE(PG8_SB(0, 1), cB + hstep, voffB); PG8_STAGE(PG8_SA(0, 1), cA + hstep, voffA);
        if (wr == 1) PG8_BAR;
        PG8_WAIT_V(4); PG8_BAR;
        PG8_STAGE(PG8_SB(1, 0), cB + kstep, voffB); PG8_STAGE(PG8_SA(1, 0), cA + kstep, voffA); PG8_STAGE(PG8_SB(1, 1), cB + hstep + kstep, voffB);
        PG8_WAIT_V(6); PG8_BAR;
    }
    for (;;) {
        const bool has_next = S.next(ui + 1, nxt);
        const char* nA = has_next ? (const char*)g.A + (size_t)nxt.pm * tstep : cA; const char* nB = has_next ? (const char*)g.Bt + (size_t)nxt.pn * tstep : cB;
        for (int t = 0; t < nt; t += 2) {
            const bool last = (t == nt - 2);
            const char* a1 = cA + (size_t)(t + 1) * kstep;
            const char* a2 = last ? nA : cA + (size_t)(t + 2) * kstep; const char* b2 = last ? nB : cB + (size_t)(t + 2) * kstep;
            const char* a3 = a2 + kstep; const char* b3 = b2 + kstep;
            if (last && has_next) S.a_ready(nxt);
            if constexpr (SP2) {
            PG8_LDB(B0, 0, 0); PG8_LDB(B1, 0, 1); PG8_SCHED; PG8_LDA(At, 0, 0); PG8_STAGE(PG8_SA(1, 1), a1 + hstep, voffA);
            PG8_WAIT_V(8); PG8_WAIT_L(0); PG8_BAR; PG8_MMA(0, 0, At, B0); PG8_MMA(0, 1, At, B1); PG8_BAR; PG8_SCHED;
            PG8_LDA(At, 0, 1); PG8_STAGE(PG8_SB(0, 0), b2, voffB); PG8_STAGE(PG8_SB(0, 1), b2 + hstep, voffB); PG8_STAGE(PG8_SA(0, 0), a2, voffA);
            PG8_WAIT_V(8); PG8_WAIT_L(0); PG8_BAR; PG8_MMA(1, 0, At, B0); PG8_MMA(1, 1, At, B1); PG8_BAR; PG8_SCHED;
            PG8_LDB(B0, 1, 0); PG8_LDB(B1, 1, 1); PG8_SCHED; PG8_LDA(At, 1, 0); PG8_STAGE(PG8_SA(0, 1), a2 + hstep, voffA);
            PG8_WAIT_V(8); PG8_WAIT_L(0); PG8_BAR; PG8_MMA(0, 0, At, B0); PG8_MMA(0, 1, At, B1); PG8_BAR; PG8_SCHED;
            PG8_LDA(At, 1, 1); PG8_STAGE(PG8_SB(1, 0), b3, voffB); PG8_STAGE(PG8_SB(1, 1), b3 + hstep, voffB); PG8_STAGE(PG8_SA(1, 0), a3, voffA);
            PG8_WAIT_V(8); PG8_WAIT_L(0); PG8_BAR; PG8_MMA(1, 0, At, B0); PG8_MMA(1, 1, At, B1); PG8_BAR; PG8_SCHED;
            } else {
            PG8_LDB(B0, 0, 0); PG8_SCHED; PG8_LDA(At, 0, 0); PG8_STAGE(PG8_SA(1, 1), a1 + hstep, voffA);
            PG8_WAIT_L(8); PG8_BAR; PG8_WAIT_L(0); PG8_MMA(0, 0, At, B0); PG8_BAR; PG8_SCHED;
            PG8_LDB(B1, 0, 1); PG8_STAGE(PG8_SB(0, 0), b2, voffB);
            PG8_BAR; PG8_WAIT_L(0); PG8_MMA(0, 1, At, B1); PG8_BAR;
            PG8_LDA(At, 0, 1); PG8_STAGE(PG8_SA(0, 0), a2, voffA);
            PG8_BAR; PG8_WAIT_L(0); PG8_MMA(1, 0, At, B0); PG8_BAR; PG8_SCHED;
            PG8_STAGE(PG8_SB(0, 1), b2 + hstep, voffB);
            PG8_WAIT_V(6); PG8_BAR; PG8_MMA(1, 1, At, B1); PG8_BAR;
            PG8_LDB(B0, 1, 0); PG8_SCHED; PG8_LDA(At, 1, 0); PG8_STAGE(PG8_SA(0, 1), a2 + hstep, voffA);
            PG8_WAIT_L(8); PG8_BAR; PG8_WAIT_L(0); PG8_MMA(0, 0, At, B0); PG8_BAR; PG8_SCHED;
            PG8_LDB(B1, 1, 1); PG8_STAGE(PG8_SB(1, 0), b3, voffB);
            PG8_BAR; PG8_WAIT_L(0); PG8_MMA(0, 1, At, B1); PG8_BAR;
            PG8_LDA(At, 1, 1); PG8_STAGE(PG8_SA(1, 0), a3, voffA);
            PG8_BAR; PG8_WAIT_L(0); PG8_MMA(1, 0, At, B0); PG8_BAR; PG8_SCHED;
            PG8_STAGE(PG8_SB(1, 1), b3 + hstep, voffB);
            PG8_WAIT_V(6); PG8_BAR; PG8_MMA(1, 1, At, B1); PG8_BAR;
            }
        }
        if constexpr (ALIGN_EPI) { if (wr == 0) PG8_BAR; }
        if constexpr (!Epi::AFTER_DRAIN) { E(acc, cur, wr, wc, fr, fq); S.done(cur); }
        if (!has_next) break;
#pragma unroll
        for (int a = 0; a < 2; ++a)
#pragma unroll
            for (int b = 0; b < 2; ++b)
#pragma unroll
                for (int m = 0; m < 4; ++m)
#pragma unroll
                    for (int n = 0; n < 2; ++n) acc[a][b][m][n] = (f32x4){0.f, 0.f, 0.f, 0.f};
        cur = nxt; cA = nA; cB = nB; ++ui;
        if constexpr (ALIGN_EPI) { if (wr == 1) PG8_BAR; }
    }
    PG8_WAIT_V(0);
    if constexpr (!ALIGN_EPI) { if (wr == 0) PG8_BAR; }
    PG8_BAR;
    if constexpr (Epi::AFTER_DRAIN) { E.fused(acc, cur, wr, wc, fr, fq, lds, wid, lane); S.done(cur); }
#undef PG8_SA
#undef PG8_SB
#undef PG8_STAGE
#undef PG8_LDA
#undef PG8_LDB
#undef PG8_MMA
#undef PG8_WAIT_V
#undef PG8_WAIT_L
#undef PG8_BAR
#undef PG8_SCHED
}
}
#define XB_TMO      128
#define XB_XCNT(j)  (256  + 64 * (j))
#define XB_XSUB(j)  (1280 + 64 * (j))
#define XB_XGEN(j)  (2304 + 64 * (j))
#define XB_TOP      3328
#define XB_TOPGEN   3392
#define XCD_BAR_WORDS 3456
#define XB_SPIN_CAP (1u << 18)
#define LAS __attribute__((address_space(3)))

__device__ __forceinline__ unsigned xb_ld(unsigned* p)              { return __hip_atomic_load(p, __ATOMIC_RELAXED, __HIP_MEMORY_SCOPE_AGENT); }
__device__ __forceinline__ unsigned xb_add(unsigned* p, unsigned v) { return __hip_atomic_fetch_add(p, v, __ATOMIC_RELAXED, __HIP_MEMORY_SCOPE_AGENT); }
__device__ __forceinline__ unsigned xb_xcc_id() { return (unsigned)__builtin_amdgcn_s_getreg((3 << 11) | 20) & 0xFu; }
#define XB_SPIN(cond, bar) do { unsigned _sp = 0; while (cond) { __builtin_amdgcn_s_sleep(1); \
    if ((++_sp & 255u) == 0u) { if (xb_ld(&(bar)[XB_TMO])) break; if (_sp > XB_SPIN_CAP) { atomicAdd(&(bar)[XB_TMO], 1u); break; } } } } while (0)

struct XcdBarrier {
    unsigned* bar; unsigned x;
    volatile LAS unsigned* st;
};

__device__ __forceinline__ XcdBarrier xcd_barrier_post(unsigned* bar, volatile LAS unsigned* st) {
    XcdBarrier b; b.bar = bar; b.x = xb_xcc_id(); b.st = st;
    if (threadIdx.x == 0) (void)xb_add(&bar[XB_XCNT(b.x)], 1u);
    return b;
}
__device__ __forceinline__ void xcd_barrier_complete(unsigned* bar, unsigned x, unsigned& nloc, unsigned& nx) {
    const unsigned G = gridDim.x * gridDim.y * gridDim.z;
    unsigned sum, cnt, mine, sp = 0u;
    for (;;) {
        sum = 0u; cnt = 0u; mine = 0u;
#pragma unroll
        for (unsigned j = 0; j < 16; ++j) { const unsigned c = xb_ld(&bar[XB_XCNT(j)]); sum += c; cnt += (c > 0u) ? 1u : 0u; mine = (j == x) ? c : mine; }
        if (sum == G) break;
        __builtin_amdgcn_s_sleep(1);
        if ((++sp & 255u) == 0u) { if (xb_ld(&bar[XB_TMO])) break; if (sp > XB_SPIN_CAP) { atomicAdd(&bar[XB_TMO], 1u); break; } }
    }
    nloc = mine > 0u ? mine : 1u; nx = cnt > 0u ? cnt : 1u;
}

__device__ __forceinline__ void xcd_barrier(const XcdBarrier& b) {
    asm volatile("s_waitcnt vmcnt(0)" ::: "memory");
    __syncthreads();
    if (threadIdx.x == 0) {
        unsigned* bar = b.bar;
        __builtin_amdgcn_s_waitcnt(0);
        unsigned nloc = b.st[0], nx = b.st[1];
        if (nloc == 0u) { xcd_barrier_complete(bar, b.x, nloc, nx); b.st[0] = nloc; b.st[1] = nx; }
        const unsigned old = xb_add(&bar[XB_XSUB(b.x)], 1u);
        const unsigned gen = old / nloc;
        if (old + 1u == (gen + 1u) * nloc) {
            __builtin_amdgcn_fence(__ATOMIC_RELEASE, "agent");
            asm volatile("s_waitcnt vmcnt(0)" ::: "memory");
            const unsigned og = xb_add(&bar[XB_TOP], 1u);
            const unsigned tg = og / nx;
            if (og + 1u == (tg + 1u) * nx) xb_add(&bar[XB_TOPGEN], 1u);
            else XB_SPIN(xb_ld(&bar[XB_TOPGEN]) == tg, bar);
            __builtin_amdgcn_fence(__ATOMIC_ACQUIRE, "agent");
            xb_add(&bar[XB_XGEN(b.x)], 1u);
            asm volatile("s_waitcnt vmcnt(0)" ::: "memory");
        } else {
            XB_SPIN(xb_ld(&bar[XB_XGEN(b.x)]) == gen, bar);
            __builtin_amdgcn_fence(__ATOMIC_ACQUIRE, "agent");
            asm volatile("s_waitcnt vmcnt(0)" ::: "memory");
        }
    }
    __syncthreads();
}

DEVINL uint4 pack8(f32x4 a, f32x4 b) { return make_uint4(pack2(a[0], a[1]), pack2(a[2], a[3]), pack2(b[0], b[1]), pack2(b[2], b[3])); }
typedef const f32x4 (&AccRef)[2][2][4][2];

struct EpiInproj {
    static constexpr bool PERM = true, AFTER_DRAIN = false;
    bf16_t *sbq, *sbk, *sbvT, *dq, *dk, *dvT, *iq, *ik, *gates; float* iw; const float *cosT, *sinT, *bgate;
    DEVINL void operator()(AccRef acc, const pg8::Unit& u, int wr, int wc, int fr, int fq) const {
        const int cb = u.pn * 256 + wc * 64;
        if (cb >= N1) return;
        float4 bb[2][2];
        if (cb >= GATE0) {
#pragma unroll
            for (int bj = 0; bj < 2; bj++) { bb[bj][0] = *(const float4*)(bgate + cb - GATE0 + 32 * bj + 8 * fq); bb[bj][1] = *(const float4*)(bgate + cb - GATE0 + 32 * bj + 8 * fq + 4); }
        }
        if (cb >= 1536 && cb < 2880 && !(cb >= 2176 && cb < 2304)) {
            bf16_t* dst0; float sc = 1.f; int ld;
            if (cb < 2048) { dst0 = dq + (cb - 1536); sc = 0.18033688011112042f; ld = 512; }
            else if (cb < 2176) { dst0 = dk + (cb - 2048); ld = 128; }
            else if (cb < 2816) { dst0 = iq + (cb - 2304); sc = 0.125f; ld = 512; }
            else { dst0 = ik; ld = 64; }
            const int rowb = u.pm * 256 + wr * 64 + fr;
#pragma unroll
            for (int ai = 0; ai < 2; ai++)
#pragma unroll
                for (int mh = 0; mh < 2; mh++) {
                    float4 cs[2][2][2];
#pragma unroll
                    for (int mm = 0; mm < 2; mm++)
#pragma unroll
                        for (int n = 0; n < 2; n++) {
                            const int pos = (rowb + ai * 128 + (mh * 2 + mm) * 16) & 2047;
                            cs[mm][n][0] = *(const float4*)(cosT + pos * 32 + 8 * fq + 4 * n);
                            cs[mm][n][1] = *(const float4*)(sinT + pos * 32 + 8 * fq + 4 * n);
                        }
#pragma unroll
                    for (int mm = 0; mm < 2; mm++) {
                        const int m = mh * 2 + mm;
                        bf16_t* dst = dst0 + (size_t)(rowb + ai * 128 + m * 16) * ld;
                        f32x4 o1[2], o2[2];
#pragma unroll
                        for (int n = 0; n < 2; n++) {
                            const float4 c4 = cs[mm][n][0], s4 = cs[mm][n][1];
                            const f32x4 x1 = acc[ai][0][m][n], x2 = acc[ai][1][m][n];
                            o1[n][0] = (x1[0] * c4.x - x2[0] * s4.x) * sc; o2[n][0] = (x2[0] * c4.x + x1[0] * s4.x) * sc;
                            o1[n][1] = (x1[1] * c4.y - x2[1] * s4.y) * sc; o2[n][1] = (x2[1] * c4.y + x1[1] * s4.y) * sc;
                            o1[n][2] = (x1[2] * c4.z - x2[2] * s4.z) * sc; o2[n][2] = (x2[2] * c4.z + x1[2] * s4.z) * sc;
                            o1[n][3] = (x1[3] * c4.w - x2[3] * s4.w) * sc; o2[n][3] = (x2[3] * c4.w + x1[3] * s4.w) * sc;
                        }
                        *(uint4*)(dst + 8 * fq) = pack8(o1[0], o1[1]);
                        *(uint4*)(dst + 32 + 8 * fq) = pack8(o2[0], o2[1]);
                    }
                }
            return;
        }
#pragma unroll
        for (int ai = 0; ai < 2; ai++)
#pragma unroll
            for (int m = 0; m < 4; m++) {
                const int row = u.pm * 256 + ai * 128 + wr * 64 + m * 16 + fr;
                const int pos = row & 2047, b = row >> 11;
                if (cb >= GATE0) {
#pragma unroll
                    for (int bj = 0; bj < 2; bj++) {
                        const int col = cb - GATE0 + 32 * bj + 8 * fq;
                        const float4 b0 = bb[bj][0], b1 = bb[bj][1];
                        f32x4 v0 = acc[ai][bj][m][0], v1 = acc[ai][bj][m][1];
                        v0[0] = __builtin_amdgcn_rcpf(1.f + __expf(-(v0[0] + b0.x))); v0[1] = __builtin_amdgcn_rcpf(1.f + __expf(-(v0[1] + b0.y)));
                        v0[2] = __builtin_amdgcn_rcpf(1.f + __expf(-(v0[2] + b0.z))); v0[3] = __builtin_amdgcn_rcpf(1.f + __expf(-(v0[3] + b0.w)));
                        v1[0] = __builtin_amdgcn_rcpf(1.f + __expf(-(v1[0] + b1.x))); v1[1] = __builtin_amdgcn_rcpf(1.f + __expf(-(v1[1] + b1.y)));
                        v1[2] = __builtin_amdgcn_rcpf(1.f + __expf(-(v1[2] + b1.z))); v1[3] = __builtin_amdgcn_rcpf(1.f + __expf(-(v1[3] + b1.w)));
                        *(uint4*)(gates + (size_t)row * 2048 + col) = pack8(v0, v1);
                    }
                } else if (cb < 1024) {
                    const float sc = cb < 512 ? 0.18033688011112042f : 1.f;
                    bf16_t* dst = (cb < 512 ? sbq + (size_t)row * 512 + cb : sbk + (size_t)row * 512 + (cb - 512));
#pragma unroll
                    for (int bj = 0; bj < 2; bj++) *(uint4*)(dst + 32 * bj + 8 * fq) = pack8(acc[ai][bj][m][0] * sc, acc[ai][bj][m][1] * sc);
                } else if (cb < 1536 || (cb >= 2176 && cb < 2304)) {
                    bf16_t* dst = (cb < 1536) ? sbvT + ((size_t)((b * 8 + ((cb - 1024) >> 6)) * 64)) * 2048 + pos
                                              : dvT + ((size_t)((b * 2 + ((cb - 2176) >> 6)) * 64)) * 2048 + pos;
#pragma unroll
                    for (int bj = 0; bj < 2; bj++)
#pragma unroll
                        for (int n = 0; n < 2; n++)
#pragma unroll
                            for (int r = 0; r < 4; r++) dst[(size_t)(32 * bj + 8 * fq + 4 * n + r) * 2048] = f2bf(acc[ai][bj][m][n][r]);
                } else if (cb < 2880) {
                    bf16_t* dst; float sc = 1.f;
                    if (cb < 2048) { dst = dq + (size_t)row * 512 + (cb - 1536); sc = 0.18033688011112042f; }
                    else if (cb < 2176) { dst = dk + (size_t)row * 128 + (cb - 2048); }
                    else if (cb < 2816) { dst = iq + (size_t)row * 512 + (cb - 2304); sc = 0.125f; }
                    else { dst = ik + (size_t)row * 64; }
                    f32x4 o1[2], o2[2];
#pragma unroll
                    for (int n = 0; n < 2; n++) {
                        const int i0 = 8 * fq + 4 * n;
                        const float4 c4 = *(const float4*)(cosT + pos * 32 + i0);
                        const float4 s4 = *(const float4*)(sinT + pos * 32 + i0);
                        const f32x4 x1 = acc[ai][0][m][n], x2 = acc[ai][1][m][n];
                        o1[n][0] = (x1[0] * c4.x - x2[0] * s4.x) * sc; o2[n][0] = (x2[0] * c4.x + x1[0] * s4.x) * sc;
                        o1[n][1] = (x1[1] * c4.y - x2[1] * s4.y) * sc; o2[n][1] = (x2[1] * c4.y + x1[1] * s4.y) * sc;
                        o1[n][2] = (x1[2] * c4.z - x2[2] * s4.z) * sc; o2[n][2] = (x2[2] * c4.z + x1[2] * s4.z) * sc;
                        o1[n][3] = (x1[3] * c4.w - x2[3] * s4.w) * sc; o2[n][3] = (x2[3] * c4.w + x1[3] * s4.w) * sc;
                    }
                    *(uint4*)(dst + 8 * fq) = pack8(o1[0], o1[1]);
                    *(uint4*)(dst + 32 + 8 * fq) = pack8(o2[0], o2[1]);
                } else {
                    if (fq == 0) {
                        const f32x4 v0 = acc[ai][0][m][0] * 0.35355339059327373f, v1 = acc[ai][0][m][1] * 0.35355339059327373f;
                        *(float4*)(iw + (size_t)row * 8) = make_float4(v0[0], v0[1], v0[2], v0[3]);
                        *(float4*)(iw + (size_t)row * 8 + 4) = make_float4(v1[0], v1[1], v1[2], v1[3]);
                    }
                }
            }
    }
};

struct EpiMemKV {
    static constexpr bool PERM = true, AFTER_DRAIN = false;
    bf16_t *kmem, *vmemT;
    DEVINL void operator()(AccRef acc, const pg8::Unit& u, int wr, int wc, int fr, int fq) const {
#pragma unroll
        for (int ai = 0; ai < 2; ai++)
#pragma unroll
            for (int m = 0; m < 4; m++) {
                const int row = u.pm * 256 + ai * 128 + wr * 64 + m * 16 + fr;
#pragma unroll
                for (int bj = 0; bj < 2; bj++) {
                    const int col = u.pn * 256 + bj * 128 + wc * 32 + 8 * fq;
                    if (col < 512) {
                        *(uint4*)(kmem + (size_t)row * 512 + col) = pack8(acc[ai][bj][m][0], acc[ai][bj][m][1]);
                    } else {
                        const int b = row >> 8, key = row & 255, h = (col - 512) >> 7, d0 = (col - 512) & 127;
                        bf16_t* dst = vmemT + ((size_t)((b * 4 + h) * 128 + d0)) * 256 + key;
#pragma unroll
                        for (int n = 0; n < 2; n++)
#pragma unroll
                            for (int r = 0; r < 4; r++) dst[(size_t)(4 * n + r) * 256] = f2bf(acc[ai][bj][m][n][r]);
                    }
                }
            }
    }
};

struct EpiMerge {
    static constexpr bool PERM = true, AFTER_DRAIN = false;
    const bf16_t* gates; bf16_t* merged; int accum;
    DEVINL void operator()(AccRef acc, const pg8::Unit& u, int wr, int wc, int fr, int fq) const {
#pragma unroll
        for (int ai = 0; ai < 2; ai++)
#pragma unroll
            for (int m = 0; m < 4; m++) {
                const int row = u.pm * 256 + ai * 128 + wr * 64 + m * 16 + fr;
#pragma unroll
                for (int bj = 0; bj < 2; bj++) {
                    const int col = u.pn * 256 + bj * 128 + wc * 32 + 8 * fq;
                    const uint4 g = *(const uint4*)(gates + (size_t)row * 2048 + col);
                    f32x4 v0 = acc[ai][bj][m][0], v1 = acc[ai][bj][m][1];
                    v0[0] *= bf2f(g.x & 0xffffu); v0[1] *= bf2f(g.x >> 16); v0[2] *= bf2f(g.y & 0xffffu); v0[3] *= bf2f(g.y >> 16);
                    v1[0] *= bf2f(g.z & 0xffffu); v1[1] *= bf2f(g.z >> 16); v1[2] *= bf2f(g.w & 0xffffu); v1[3] *= bf2f(g.w >> 16);
                    bf16_t* dst = merged + (size_t)row * 1024 + col;
                    if (accum) {
                        const uint4 o = *(const uint4*)dst;
                        v0[0] += bf2f(o.x & 0xffffu); v0[1] += bf2f(o.x >> 16); v0[2] += bf2f(o.y & 0xffffu); v0[3] += bf2f(o.y >> 16);
                        v1[0] += bf2f(o.z & 0xffffu); v1[1] += bf2f(o.z >> 16); v1[2] += bf2f(o.w & 0xffffu); v1[3] += bf2f(o.w >> 16);
                    }
                    *(uint4*)dst = pack8(v0, v1);
                }
            }
    }
};

template <bool F32RES>
struct EpiResid {
    static constexpr bool PERM = true, AFTER_DRAIN = false;
    const float* res32; bf16_t* hb; float* rowss;
    DEVINL void operator()(AccRef acc, const pg8::Unit& u, int wr, int wc, int fr, int fq) const {
        const int rowb = u.pm * 256 + wr * 64 + fr, colb = u.pn * 256 + wc * 32 + 8 * fq;
#pragma unroll
        for (int ai = 0; ai < 2; ai++)
#pragma unroll
        for (int mh = 0; mh < 2; mh++) {
            float4 xx[2][2][2]; uint4 oo[2][2];
#pragma unroll
            for (int mm = 0; mm < 2; mm++)
#pragma unroll
                for (int bj = 0; bj < 2; bj++) {
                    const int row = rowb + ai * 128 + (mh * 2 + mm) * 16, col = colb + bj * 128;
                    if (F32RES) { xx[mm][bj][0] = *(const float4*)(res32 + (size_t)row * 1024 + col); xx[mm][bj][1] = *(const float4*)(res32 + (size_t)row * 1024 + col + 4); }
                    else oo[mm][bj] = *(const uint4*)(hb + (size_t)row * 1024 + col);
                }
#pragma unroll
            for (int mm = 0; mm < 2; mm++) {
                const int m = mh * 2 + mm;
                const int row = rowb + ai * 128 + m * 16;
                float ss = 0.f;
#pragma unroll
                for (int bj = 0; bj < 2; bj++) {
                    const int col = colb + bj * 128;
                    f32x4 v0 = acc[ai][bj][m][0], v1 = acc[ai][bj][m][1];
                    if (F32RES) {
                        const float4 x0 = xx[mm][bj][0], x1 = xx[mm][bj][1];
                        v0[0] += x0.x; v0[1] += x0.y; v0[2] += x0.z; v0[3] += x0.w; v1[0] += x1.x; v1[1] += x1.y; v1[2] += x1.z; v1[3] += x1.w;
                    } else {
                        const uint4 o = oo[mm][bj];
                        v0[0] += bf2f(o.x & 0xffffu); v0[1] += bf2f(o.x >> 16); v0[2] += bf2f(o.y & 0xffffu); v0[3] += bf2f(o.y >> 16);
                        v1[0] += bf2f(o.z & 0xffffu); v1[1] += bf2f(o.z >> 16); v1[2] += bf2f(o.w & 0xffffu); v1[3] += bf2f(o.w >> 16);
                    }
                    *(uint4*)(hb + (size_t)row * 1024 + col) = pack8(v0, v1);
                    ss += v0[0] * v0[0] + v0[1] * v0[1] + v0[2] * v0[2] + v0[3] * v0[3] + v1[0] * v1[0] + v1[1] * v1[1] + v1[2] * v1[2] + v1[3] * v1[3];
                }
                ss += __shfl_xor(ss, 16); ss += __shfl_xor(ss, 32);
                if (fq == 0) atomicAdd(rowss + row, ss);
            }
        }
    }
};

struct EpiFinal {
    static constexpr bool PERM = true, AFTER_DRAIN = true;
    const bf16_t* hb; float* out; const float* gfin; float* X; unsigned* cnt;
    DEVINL void operator()(AccRef, const pg8::Unit&, int, int, int, int) const {}
    DEVINL void fused(f32x4 (&acc)[2][2][4][2], const pg8::Unit& u, int wr, int wc, int fr, int fq, __attribute__((address_space(3))) unsigned char* ldsb, int, int) const {
        float* part = (float*)(ldsb + 131072);
        float* rsb = part + 1024;
        const int tid = threadIdx.x;
#pragma unroll
        for (int ai = 0; ai < 2; ai++) {
            uint4 oo[4][2];
#pragma unroll
            for (int m = 0; m < 4; m++)
#pragma unroll
                for (int bj = 0; bj < 2; bj++)
                    oo[m][bj] = *(const uint4*)(hb + (size_t)(u.pm * 256 + ai * 128 + wr * 64 + m * 16 + fr) * 1024 + u.pn * 256 + bj * 128 + wc * 32 + 8 * fq);
#pragma unroll
            for (int m = 0; m < 4; m++) {
                const int rowl = ai * 128 + wr * 64 + m * 16 + fr;
                float ss = 0.f;
#pragma unroll
                for (int bj = 0; bj < 2; bj++) {
                    const uint4 o = oo[m][bj];
                    f32x4& v0 = acc[ai][bj][m][0]; f32x4& v1 = acc[ai][bj][m][1];
                    v0[0] += bf2f(o.x & 0xffffu); v0[1] += bf2f(o.x >> 16); v0[2] += bf2f(o.y & 0xffffu); v0[3] += bf2f(o.y >> 16);
                    v1[0] += bf2f(o.z & 0xffffu); v1[1] += bf2f(o.z >> 16); v1[2] += bf2f(o.w & 0xffffu); v1[3] += bf2f(o.w >> 16);
                    ss += v0[0] * v0[0] + v0[1] * v0[1] + v0[2] * v0[2] + v0[3] * v0[3] + v1[0] * v1[0] + v1[1] * v1[1] + v1[2] * v1[2] + v1[3] * v1[3];
                }
                ss += __shfl_xor(ss, 16); ss += __shfl_xor(ss, 32);
                if (fq == 0) part[wc * 256 + rowl] = ss;
            }
        }
        __syncthreads();
        if (tid < 256) __hip_atomic_store(X + (size_t)(u.pm * 4 + u.pn) * 256 + tid, (part[tid] + part[256 + tid]) + (part[512 + tid] + part[768 + tid]), __ATOMIC_RELAXED, __HIP_MEMORY_SCOPE_AGENT);
        asm volatile("s_waitcnt vmcnt(0)" ::: "memory");
        __syncthreads();
        if (tid == 0) {
            __hip_atomic_fetch_add(cnt + u.pm, 1u, __ATOMIC_RELAXED, __HIP_MEMORY_SCOPE_AGENT);
            unsigned spins = 0;
            while (__hip_atomic_load(cnt + u.pm, __ATOMIC_RELAXED, __HIP_MEMORY_SCOPE_AGENT) < 4u) { __builtin_amdgcn_s_sleep(1); if (++spins > (1u << 22)) break; }
        }
        __syncthreads();
        if (tid < 256) {
            float* xp = X + (size_t)(u.pm * 4) * 256 + tid;
            const float s = (__hip_atomic_load(xp, __ATOMIC_RELAXED, __HIP_MEMORY_SCOPE_AGENT) + __hip_atomic_load(xp + 256, __ATOMIC_RELAXED, __HIP_MEMORY_SCOPE_AGENT)) +
                            (__hip_atomic_load(xp + 512, __ATOMIC_RELAXED, __HIP_MEMORY_SCOPE_AGENT) + __hip_atomic_load(xp + 768, __ATOMIC_RELAXED, __HIP_MEMORY_SCOPE_AGENT));
            rsb[tid] = __builtin_amdgcn_rsqf(s * (1.f / 1024.f) + EPS);
        }
        float4 gg[2][2];
#pragma unroll
        for (int bj = 0; bj < 2; bj++) { gg[bj][0] = *(const float4*)(gfin + u.pn * 256 + bj * 128 + wc * 32 + 8 * fq); gg[bj][1] = *(const float4*)(gfin + u.pn * 256 + bj * 128 + wc * 32 + 8 * fq + 4); }
        __syncthreads();
#pragma unroll
        for (int ai = 0; ai < 2; ai++)
#pragma unroll
            for (int m = 0; m < 4; m++) {
                const int rowl = ai * 128 + wr * 64 + m * 16 + fr;
                const int row = u.pm * 256 + rowl;
                const float rs = rsb[rowl];
#pragma unroll
                for (int bj = 0; bj < 2; bj++) {
                    const int col = u.pn * 256 + bj * 128 + wc * 32 + 8 * fq;
                    const float4 g0 = gg[bj][0], g1 = gg[bj][1];
                    const f32x4 v0 = acc[ai][bj][m][0] * rs, v1 = acc[ai][bj][m][1] * rs;
                    *(float4*)(out + (size_t)row * 1024 + col) = make_float4(v0[0] * g0.x, v0[1] * g0.y, v0[2] * g0.z, v0[3] * g0.w);
                    *(float4*)(out + (size_t)row * 1024 + col + 4) = make_float4(v1[0] * g1.x, v1[1] * g1.y, v1[2] * g1.z, v1[3] * g1.w);
                }
            }
    }
};

struct EpiCq {
    static constexpr bool PERM = true, AFTER_DRAIN = false;
    const float* rowss1; bf16_t* qc;
    DEVINL void operator()(AccRef acc, const pg8::Unit& u, int wr, int wc, int fr, int fq) const {
        float rsv[2][4];
#pragma unroll
        for (int ai = 0; ai < 2; ai++)
#pragma unroll
            for (int m = 0; m < 4; m++) rsv[ai][m] = rowss1[u.pm * 256 + ai * 128 + wr * 64 + m * 16 + fr];
#pragma unroll
        for (int ai = 0; ai < 2; ai++)
#pragma unroll
            for (int m = 0; m < 4; m++) {
                const int row = u.pm * 256 + ai * 128 + wr * 64 + m * 16 + fr;
                const float rs = __builtin_amdgcn_rsqf(rsv[ai][m] * (1.f / 1024.f) + EPS) * 0.12751743074602467f;
#pragma unroll
                for (int bj = 0; bj < 2; bj++)
                    *(uint4*)(qc + (size_t)row * 512 + u.pn * 256 + bj * 128 + wc * 32 + 8 * fq) = pack8(acc[ai][bj][m][0] * rs, acc[ai][bj][m][1] * rs);
            }
    }
};

struct EpiUp {
    static constexpr bool PERM = true, AFTER_DRAIN = false;
    const float* rowss2; bf16_t* hdn;
    DEVINL void operator()(AccRef acc, const pg8::Unit& u, int wr, int wc, int fr, int fq) const {
        float rsv[2][4];
#pragma unroll
        for (int ai = 0; ai < 2; ai++)
#pragma unroll
            for (int m = 0; m < 4; m++) rsv[ai][m] = rowss2[u.pm * 256 + ai * 128 + wr * 64 + m * 16 + fr];
#pragma unroll
        for (int ai = 0; ai < 2; ai++)
#pragma unroll
            for (int m = 0; m < 4; m++) {
                const int row = u.pm * 256 + ai * 128 + wr * 64 + m * 16 + fr;
                const float rs = __builtin_amdgcn_rsqf(rsv[ai][m] * (1.f / 1024.f) + EPS);
#pragma unroll
                for (int bj = 0; bj < 2; bj++) {
                    f32x4 v0 = acc[ai][bj][m][0] * rs, v1 = acc[ai][bj][m][1] * rs;
#pragma unroll
                    for (int r = 0; r < 4; r++) { v0[r] = fmaxf(v0[r], 0.f); v1[r] = fmaxf(v1[r], 0.f); }
                    *(uint4*)(hdn + (size_t)row * 4096 + u.pn * 256 + bj * 128 + wc * 32 + 8 * fq) = pack8(v0 * v0, v1 * v1);
                }
            }
    }
};

constexpr int LDP = 72;
struct MergeOrder {
    pg8::StaticOrder S;
    DEVINL bool next(int i, pg8::Unit& u) const { pg8::Unit t; if (!S.next(i >> 1, t)) return false; u.pm = t.pm + 64 * (i & 1); u.pn = t.pn + 4 * (i & 1); return true; }
    DEVINL void a_ready(const pg8::Unit&) const {}
    DEVINL void done(const pg8::Unit&) const {}
};
struct EpiMerge2 {
    static constexpr bool PERM = true, AFTER_DRAIN = false;
    const bf16_t* gates; bf16_t* merged;
    DEVINL void operator()(AccRef acc, const pg8::Unit& u, int wr, int wc, int fr, int fq) const {
        const int second = u.pm >= 64;
        const int pm = u.pm & 63, pn = u.pn & 3;
        const int rowb = pm * 256 + wr * 64 + fr, colb = pn * 256 + wc * 32 + 8 * fq;
#pragma unroll
        for (int ai = 0; ai < 2; ai++)
#pragma unroll
        for (int mh = 0; mh < 2; mh++) {
            uint4 gg[2][2], oo[2][2];
#pragma unroll
            for (int mm = 0; mm < 2; mm++)
#pragma unroll
                for (int bj = 0; bj < 2; bj++) {
                    const int row = rowb + ai * 128 + (mh * 2 + mm) * 16, col = colb + bj * 128;
                    gg[mm][bj] = *(const uint4*)(gates + (size_t)row * 2048 + second * 1024 + col);
                    if (second) oo[mm][bj] = *(const uint4*)(merged + (size_t)row * 1024 + col);
                }
#pragma unroll
            for (int mm = 0; mm < 2; mm++)
#pragma unroll
                for (int bj = 0; bj < 2; bj++) {
                    const int m = mh * 2 + mm;
                    const int row = rowb + ai * 128 + m * 16, col = colb + bj * 128;
                    const uint4 g = gg[mm][bj];
                    f32x4 v0 = acc[ai][bj][m][0], v1 = acc[ai][bj][m][1];
                    v0[0] *= bf2f(g.x & 0xffffu); v0[1] *= bf2f(g.x >> 16); v0[2] *= bf2f(g.y & 0xffffu); v0[3] *= bf2f(g.y >> 16);
                    v1[0] *= bf2f(g.z & 0xffffu); v1[1] *= bf2f(g.z >> 16); v1[2] *= bf2f(g.w & 0xffffu); v1[3] *= bf2f(g.w >> 16);
                    if (second) {
                        const uint4 o = oo[mm][bj];
                        v0[0] += bf2f(o.x & 0xffffu); v0[1] += bf2f(o.x >> 16); v0[2] += bf2f(o.y & 0xffffu); v0[3] += bf2f(o.y >> 16);
                        v1[0] += bf2f(o.z & 0xffffu); v1[1] += bf2f(o.z >> 16); v1[2] += bf2f(o.w & 0xffffu); v1[3] += bf2f(o.w >> 16);
                    }
                    *(uint4*)(merged + (size_t)row * 1024 + col) = pack8(v0, v1);
                }
        }
    }
};

typedef __attribute__((address_space(3))) unsigned char* lds_ptr_t;
template <class Epi, bool MULTI>
DEVINL void run_gemm(unsigned char* lds, const bf16_t* A, const bf16_t* Bt, int M, int N, int K, const Epi& E, int c_override = -1) {
    pg8::Gemm g{A, Bt, M, N, K};
    pg8::StaticOrder S; S.init(M, N, (int)gridDim.x, c_override >= 0 ? c_override : (int)blockIdx.x);
    pg8::gemm_phase<Epi, pg8::StaticOrder, MULTI, true>((lds_ptr_t)lds, g, S, E);
}

DEVINL void phase_inproj(const KParams& p, unsigned char* lds) {
    unsigned char* ws = p.ws;
    EpiInproj E{(bf16_t*)(ws + OFF_SBQ), (bf16_t*)(ws + OFF_SBK), (bf16_t*)(ws + OFF_SBVT), (bf16_t*)(ws + OFF_DQ), (bf16_t*)(ws + OFF_DK), (bf16_t*)(ws + OFF_DVT),
                (bf16_t*)(ws + OFF_IQ), (bf16_t*)(ws + OFF_IK), (bf16_t*)(ws + OFF_GATES), (float*)(ws + OFF_IW),
                (const float*)(ws + OFF_ROPEC), (const float*)(ws + OFF_ROPES), p.in[7]};
    run_gemm<EpiInproj, true>(lds, (const bf16_t*)(ws + OFF_U0), (const bf16_t*)(ws + OFF_WT1), 16384, N1P, 1024, E);
}

#ifndef REP_A
#define REP_A 1
#endif
#ifndef REP_B
#define REP_B 1
#endif
#ifndef REP_C
#define REP_C 1
#endif
#ifndef REP_SB
#define REP_SB 1
#endif
template <int CTRL> DEVINL float dpp_f(float v) { return __builtin_bit_cast(float, __builtin_amdgcn_update_dpp(0, __builtin_bit_cast(int, v), CTRL, 0xF, 0xF, true)); }
template <int CTRL> DEVINL int dpp_i(int v) { return __builtin_amdgcn_update_dpp(0, v, CTRL, 0xF, 0xF, true); }
DEVINL int wave_sum_i_fast(int v) {
    v += dpp_i<0xB1>(v); v += dpp_i<0x4E>(v); v += dpp_i<0x141>(v); v += dpp_i<0x140>(v);
    { auto r = __builtin_amdgcn_permlane16_swap((unsigned)v, (unsigned)v, false, false); v = (int)(r[0] + r[1]); }
    { auto r = __builtin_amdgcn_permlane32_swap((unsigned)v, (unsigned)v, false, false); v = (int)(r[0] + r[1]); }
    return v;
}
DEVINL float lq_max(float v) {
    { auto r = __builtin_amdgcn_permlane16_swap(__float_as_uint(v), __float_as_uint(v), false, false); v = fmaxf(__uint_as_float(r[0]), __uint_as_float(r[1])); }
    { auto r = __builtin_amdgcn_permlane32_swap(__float_as_uint(v), __float_as_uint(v), false, false); v = fmaxf(__uint_as_float(r[0]), __uint_as_float(r[1])); }
    return v;
}
DEVINL float lq_sum(float v) {
    { auto r = __builtin_amdgcn_permlane16_swap(__float_as_uint(v), __float_as_uint(v), false, false); v = __uint_as_float(r[0]) + __uint_as_float(r[1]); }
    { auto r = __builtin_amdgcn_permlane32_swap(__float_as_uint(v), __float_as_uint(v), false, false); v = __uint_as_float(r[0]) + __uint_as_float(r[1]); }
    return v;
}
#define QUAD_XOR1 0xB1
#define QUAD_XOR2 0x4E
DEVINL int opaque_tid() { int t = threadIdx.x; asm volatile("" : "+v"(t)); return t; }
#define WAVE_LDS_SYNC() do { __builtin_amdgcn_fence(__ATOMIC_RELEASE, "wavefront"); __builtin_amdgcn_wave_barrier(); __builtin_amdgcn_fence(__ATOMIC_ACQUIRE, "wavefront"); } while (0)
DEVINL void sb_unit(const KParams& p, unsigned char* lds, int b, int hp, int qt) {
    unsigned char* ws = p.ws;
    const bf16_t* sbq = (const bf16_t*)(ws + OFF_SBQ); const bf16_t* sbk = (const bf16_t*)(ws + OFF_SBK); const bf16_t* sbvT = (const bf16_t*)(ws + OFF_SBVT);
    bf16_t* osb = (bf16_t*)(ws + OFF_OSB);
    bf16_t* Ks = (bf16_t*)lds;
    bf16_t* Vt = Ks + 2 * 64 * LDP;
    float* Ls = (float*)(lds + 8 * 64 * LDP * 2);
    const int tid = opaque_tid(), lane = tid & 63, wave = __builtin_amdgcn_readfirstlane(tid >> 6), lr = lane & 15, lq = lane >> 4;
    const int hw = wave >> 2, h = 2 * hp + hw;
    const int t0 = qt * 64, tw0 = t0 + (wave & 3) * 16;
    const size_t tokbase = (size_t)b * 2048;
    bf16x8 qf[2];
    qf[0] = *(const bf16x8*)(sbq + (tokbase + tw0 + lr) * 512 + h * 64 + lq * 8);
    qf[1] = *(const bf16x8*)(sbq + (tokbase + tw0 + lr) * 512 + h * 64 + 32 + lq * 8);
    f32x4 oacc[4];
#pragma unroll
    for (int n = 0; n < 4; n++) oacc[n] = f32x4{0.f, 0.f, 0.f, 0.f};
    float carry = 0.f;
    const int srow = lane >> 2, sq = lane & 3;
    const int t_s = tw0 + srow;
    float* Lrow_w = Ls + (wave * 16 + lr) * 68;
    float* Lrow_s = Ls + (wave * 16 + srow) * 68;
    const int cr = tid >> 3, cc = (tid & 7) * 8;
    const bf16_t* kg = sbk + (tokbase + cr) * 512 + 2 * hp * 64 + cc;
    const bf16_t* vg = sbvT + ((size_t)((b * 8 + 2 * hp) * 64 + cr)) * 2048 + cc;
    int jt = qt;
    {
        const uint4 pk = *(const uint4*)(kg + (size_t)jt * 64 * 512), pk2 = *(const uint4*)(kg + (size_t)jt * 64 * 512 + 64);
        const uint4 pv = *(const uint4*)(vg + jt * 64), pv2 = *(const uint4*)(vg + (size_t)64 * 2048 + jt * 64);
        *(uint4*)(Ks + cr * LDP + cc) = pk; *(uint4*)(Ks + (64 + cr) * LDP + cc) = pk2;
        *(uint4*)(Vt + cr * LDP + cc) = pv; *(uint4*)(Vt + (64 + cr) * LDP + cc) = pv2;
    }
    __builtin_amdgcn_s_waitcnt(0x0F70);
    __syncthreads();
    int buf = 0;
    for (; jt >= 0; --jt, buf ^= 1) {
        const int j0 = jt * 64;
        uint4 pk, pv, pk2, pv2;
        if (jt > 0) {
            pk = *(const uint4*)(kg + (size_t)(jt - 1) * 64 * 512); pk2 = *(const uint4*)(kg + (size_t)(jt - 1) * 64 * 512 + 64);
            pv = *(const uint4*)(vg + (jt - 1) * 64); pv2 = *(const uint4*)(vg + (size_t)64 * 2048 + (jt - 1) * 64);
        }
        const bf16_t* Kc = Ks + buf * (4 * 64 * LDP) + hw * 64 * LDP;
        const bf16_t* Vc = Vt + buf * (4 * 64 * LDP) + hw * 64 * LDP;
        if (j0 < tw0 + 16 && __ballot(carry < 64.f) != 0ull) {
            f32x4 lg[4];
#pragma unroll
            for (int n = 0; n < 4; n++) lg[n] = f32x4{0.f, 0.f, 0.f, 0.f};
#pragma unroll
            for (int ks = 0; ks < 2; ks++)
#pragma unroll
                for (int n = 0; n < 4; n++) {
                    const bf16x8 kf = *(const bf16x8*)(Kc + (n * 16 + lr) * LDP + ks * 32 + lq * 8);
                    lg[n] = mfma16(kf, qf[ks], lg[n]);
                }
            const int t_r = tw0 + lr;
            float spv[4][4], tot[4], hi[4];
#pragma unroll
            for (int n = 0; n < 4; n++) {
                float g = 0.f;
#pragma unroll
                for (int r = 0; r < 4; r++) {
                    const float z = lg[n][r];
                    const float s2 = fmaxf(z, 0.f) + __builtin_amdgcn_logf(1.f + __builtin_amdgcn_exp2f(-fabsf(z)));
                    spv[n][r] = (j0 + n * 16 + lq * 4 + r < t_r) ? s2 : 0.f;
                    g += spv[n][r];
                }
                const auto r16 = __builtin_amdgcn_permlane16_swap(__float_as_uint(g), __float_as_uint(g), false, false);
                const float x16 = __uint_as_float((lq & 1) ? r16[0] : r16[1]);
                const auto r32 = __builtin_amdgcn_permlane32_swap(__float_as_uint(g), __float_as_uint(g), false, false);
                const float x32 = __uint_as_float((lq >= 2) ? r32[0] : r32[1]);
                const auto r48 = __builtin_amdgcn_permlane16_swap(__float_as_uint(x32), __float_as_uint(x32), false, false);
                const float x48 = __uint_as_float((lq & 1) ? r48[0] : r48[1]);
                tot[n] = (g + x16) + (x32 + x48);
                hi[n] = ((lq & 1) ? 0.f : x16) + ((lq < 2) ? (x32 + x48) : 0.f);
            }
            float base = carry;
#pragma unroll
            for (int n = 3; n >= 0; n--) {
                float run = base + hi[n];
#pragma unroll
                for (int r = 3; r >= 0; r--) {
                    run += spv[n][r];
                    lg[n][r] = (j0 + n * 16 + lq * 4 + r < t_r) ? __builtin_amdgcn_exp2f(lg[n][r] - run) : 0.f;
                }
                base += tot[n];
            }
            carry = base;
#pragma unroll
            for (int ks = 0; ks < 2; ks++) {
                const uint4 pu = make_uint4(pack2(lg[2 * ks][0], lg[2 * ks][1]), pack2(lg[2 * ks][2], lg[2 * ks][3]),
                                            pack2(lg[2 * ks + 1][0], lg[2 * ks + 1][1]), pack2(lg[2 * ks + 1][2], lg[2 * ks + 1][3]));
                const bf16x8 pf = __builtin_bit_cast(bf16x8, pu);
#pragma unroll
                for (int n = 0; n < 4; n++) {
                    const bf16_t* vrow = Vc + (n * 16 + lr) * LDP + ks * 32 + lq * 4;
                    const uint2 v0 = *(const uint2*)(vrow), v1 = *(const uint2*)(vrow + 16);
                    const bf16x8 vf = __builtin_bit_cast(bf16x8, make_uint4(v0.x, v0.y, v1.x, v1.y));
                    oacc[n] = mfma16(vf, pf, oacc[n]);
                }
            }
        }
        if (jt > 0) {
            bf16_t* Kn = Ks + (buf ^ 1) * (4 * 64 * LDP); bf16_t* Vn = Vt + (buf ^ 1) * (4 * 64 * LDP);
            *(uint4*)(Kn + cr * LDP + cc) = pk; *(uint4*)(Kn + (64 + cr) * LDP + cc) = pk2;
            *(uint4*)(Vn + cr * LDP + cc) = pv; *(uint4*)(Vn + (64 + cr) * LDP + cc) = pv2;
        }
        {
            int* dflag = (int*)(lds + 8 * 64 * LDP * 2) + buf * 8;
            if (lane == 0) dflag[wave] = (__ballot(carry < 64.f) == 0ull) ? 1 : 0;
            __syncthreads();
            const int4 f0 = *(const int4*)dflag, f1 = *(const int4*)(dflag + 4);
            if ((f0.x & f0.y & f0.z & f0.w & f1.x & f1.y & f1.z & f1.w) != 0) break;
        }
    }
#pragma unroll
    for (int n = 0; n < 4; n++)
        *(uint2*)(osb + (tokbase + tw0 + lr) * 512 + h * 64 + n * 16 + lq * 4) = pack4(oacc[n]);
}

DEVINL void dsa_unit(const KParams& p, unsigned char* lds, int b, int qt) {
    unsigned char* ws = p.ws;
    const bf16_t* dq = (const bf16_t*)(ws + OFF_DQ); const bf16_t* dk = (const bf16_t*)(ws + OFF_DK); const bf16_t* dvT = (const bf16_t*)(ws + OFF_DVT);
    const bf16_t* iq = (const bf16_t*)(ws + OFF_IQ); const bf16_t* ik = (const bf16_t*)(ws + OFF_IK); const float* iw = (const float*)(ws + OFF_IW);
    bf16_t* odsa = (bf16_t*)(ws + OFF_ODSA);
    unsigned short* Skey = (unsigned short*)lds;
    unsigned* Sel = (unsigned*)(lds + 131072);
    bf16_t* const KB0 = (bf16_t*)lds;
    bf16_t* const KB1 = (bf16_t*)(lds + 36864);
    const int tid = opaque_tid(), lane = tid & 63, wave = __builtin_amdgcn_readfirstlane(tid >> 6), lr = lane & 15, lq = lane >> 4;
    const int t0 = qt * 32;
    const size_t tokbase = (size_t)b * 2048;

    for (int repa = 0; repa < REP_A; repa++)
#pragma unroll 1
    for (int th = 0; th < 2; th++) {
        bf16x8 iqf[8][2];
        const bf16_t* iqrow = iq + (tokbase + t0 + th * 16 + lr) * 512 + lq * 8;
#pragma unroll
        for (int hh = 0; hh < 8; hh++) {
            iqf[hh][0] = *(const bf16x8*)(iqrow + hh * 64);
            iqf[hh][1] = *(const bf16x8*)(iqrow + hh * 64 + 32);
        }
        float wv[4][8];
#pragma unroll
        for (int r = 0; r < 4; r++) {
            const float4 a = *(const float4*)(iw + (tokbase + t0 + th * 16 + lq * 4 + r) * 8);
            const float4 c = *(const float4*)(iw + (tokbase + t0 + th * 16 + lq * 4 + r) * 8 + 4);
            wv[r][0] = a.x; wv[r][1] = a.y; wv[r][2] = a.z; wv[r][3] = a.w; wv[r][4] = c.x; wv[r][5] = c.y; wv[r][6] = c.z; wv[r][7] = c.w;
        }
        const int nsub = 2 * qt + 1 + th;
        const bf16_t* ikbase = ik + (tokbase + lr) * 64 + lq * 8;
        unsigned short* Srow = Skey + (th * 16 + lq * 4) * 2048 + lr;
        bf16x8 ka0 = bf16x8{0, 0, 0, 0, 0, 0, 0, 0}, ka1 = ka0, kb0 = ka0, kb1 = ka0;
        if (wave < nsub) { ka0 = *(const bf16x8*)(ikbase + (size_t)wave * 1024); ka1 = *(const bf16x8*)(ikbase + (size_t)wave * 1024 + 32); }
        if (wave + 8 < nsub) { kb0 = *(const bf16x8*)(ikbase + (size_t)(wave + 8) * 1024); kb1 = *(const bf16x8*)(ikbase + (size_t)(wave + 8) * 1024 + 32); }
        __builtin_amdgcn_s_waitcnt(0x0F70);
        for (int st = wave; st < nsub; st += 16) {
            const bf16x8 a0 = ka0, a1 = ka1, b0 = kb0, b1 = kb1;
            if (st + 16 < nsub) { ka0 = *(const bf16x8*)(ikbase + (size_t)(st + 16) * 1024); ka1 = *(const bf16x8*)(ikbase + (size_t)(st + 16) * 1024 + 32); }
            if (st + 24 < nsub) { kb0 = *(const bf16x8*)(ikbase + (size_t)(st + 24) * 1024); kb1 = *(const bf16x8*)(ikbase + (size_t)(st + 24) * 1024 + 32); }
            float sa[4] = {0.f, 0.f, 0.f, 0.f}, sb[4] = {0.f, 0.f, 0.f, 0.f};
#pragma unroll
            for (int hh = 0; hh < 8; hh++) {
                f32x4 xa = f32x4{0.f, 0.f, 0.f, 0.f}, xb = f32x4{0.f, 0.f, 0.f, 0.f};
                xa = mfma16(iqf[hh][0], a0, xa);
                xb = mfma16(iqf[hh][0], b0, xb);
                xa = mfma16(iqf[hh][1], a1, xa);
                xb = mfma16(iqf[hh][1], b1, xb);
#pragma unroll
                for (int r = 0; r < 4; r++) { sa[r] += fmaxf(xa[r], 0.f) * wv[r][hh]; sb[r] += fmaxf(xb[r], 0.f) * wv[r][hh]; }
            }
#pragma unroll
            for (int r = 0; r < 4; r++) Srow[r * 2048 + st * 16] = f2key(sa[r]);
            if (st + 8 < nsub) {
#pragma unroll
                for (int r = 0; r < 4; r++) Srow[r * 2048 + (st + 8) * 16] = f2key(sb[r]);
            }
        }
    }
    __syncthreads();

#pragma unroll 1
    for (int rr = 0; rr < 4 * REP_B; rr++) {
        const int tl = wave * 4 + (rr & 3);
        const int t = t0 + tl;
        const int nch = (t >> 6) + 1;
        unsigned key[32];
#pragma unroll
        for (int c = 0; c < 32; c++) {
            const int s = c * 64 + lane;
            key[c] = (s <= t) ? (unsigned)Skey[tl * 2048 + s] : 0u;
        }
        unsigned Tc = 1;
        int scut = t;
        if (t >= 256) {
            unsigned* hist = (unsigned*)(lds + 139392) + wave * 256;
            unsigned B1 = 0; int above1 = 0, neq = 0;
#pragma unroll 1
            for (int lvl = 0; lvl < 2; lvl++) {
                *(uint4*)(hist + lane * 4) = make_uint4(0u, 0u, 0u, 0u);
#pragma unroll
                for (int c4 = 0; c4 < 8; c4++)
                    if (c4 * 4 < nch) {
#pragma unroll
                        for (int c = c4 * 4; c < c4 * 4 + 4; c++) {
                            if (lvl == 0) atomicAdd(hist + (key[c] >> 8), 1u);
                            else if ((key[c] >> 8) == B1) atomicAdd(hist + (key[c] & 255u), 1u);
                        }
                    }
                const uint4 hb4 = *(const uint4*)(hist + lane * 4);
                const int sl = (int)(hb4.x + hb4.y + hb4.z + hb4.w);
                int v = sl;
                v += dpp_i<0x111>(v); v += dpp_i<0x112>(v); v += dpp_i<0x114>(v); v += dpp_i<0x118>(v);
                const int r0 = __builtin_amdgcn_readlane(v, 15), r1 = __builtin_amdgcn_readlane(v, 31), r2 = __builtin_amdgcn_readlane(v, 47), r3 = __builtin_amdgcn_readlane(v, 63);
                v += (lq >= 1 ? r0 : 0) + (lq >= 2 ? r1 : 0) + (lq >= 3 ? r2 : 0);
                const int total = r0 + r1 + r2 + r3;
                const int target = (lvl == 0) ? 256 : 256 - above1;
                const int sx = total - v;
                const bool owner = (sx < target) && (sx + sl >= target);
                int bin, abv;
                {
                    const int c3 = sx + (int)hb4.w, c2 = c3 + (int)hb4.z, c1 = c2 + (int)hb4.y;
                    if (c3 >= target) { bin = 3; abv = sx; }
                    else if (c2 >= target) { bin = 2; abv = c3; }
                    else if (c1 >= target) { bin = 1; abv = c2; }
                    else { bin = 0; abv = c1; }
                }
                const int cntb = bin == 3 ? (int)hb4.w : bin == 2 ? (int)hb4.z : bin == 1 ? (int)hb4.y : (int)hb4.x;
                const int src = __ffsll((long long)__ballot(owner)) - 1;
                const int obin = __builtin_amdgcn_readlane(bin, src) + 4 * src;
                const int oabv = __builtin_amdgcn_readlane(abv, src);
                if (lvl == 0) { B1 = (unsigned)obin; above1 = oabv; }
                else { Tc = (B1 << 8) | (unsigned)obin; above1 += oabv; neq = __builtin_amdgcn_readlane(cntb, src); }
            }
            const int need = 256 - above1;
            if (neq != need) {
                int cum = 0;
                bool found = false;
#pragma unroll
                for (int c = 0; c < 32; c++) {
                    const unsigned long long m = __ballot(key[c] == Tc);
                    const int pc = __popcll(m);
                    if (!found && cum + pc >= need) {
                        const int kth = need - cum;
                        const int pre = __popcll(m & ((2ull << lane) - 1ull));
                        const bool me = ((m >> lane) & 1ull) && (pre == kth);
                        const unsigned long long mm = __ballot(me);
                        scut = c * 64 + (__ffsll((long long)mm) - 1);
                        found = true;
                    }
                    cum += pc;
                }
            }
        }
        unsigned mlo = 0u, mhi = 0u;
#pragma unroll
        for (int c4 = 0; c4 < 8; c4++)
            if (c4 * 4 < nch) {
#pragma unroll
                for (int c = c4 * 4; c < c4 * 4 + 4; c++) {
                    const int s = c * 64 + lane;
                    const bool sel = (s <= t) && (key[c] > Tc || (key[c] == Tc && s <= scut));
                    const unsigned long long m = __ballot(sel);
                    if (lane == c) { mlo = (unsigned)m; mhi = (unsigned)(m >> 32); }
                }
            }
        if (lane < 32) { Sel[tl * 65 + lane * 2] = mlo; Sel[tl * 65 + lane * 2 + 1] = mhi; }
    }
    __syncthreads();

    for (int repc = 0; repc < REP_C; repc++) {
        const int hd = wave, g = wave >> 2;
        bf16x8 qf[2][2];
#pragma unroll
        for (int rg = 0; rg < 2; rg++) {
            qf[rg][0] = *(const bf16x8*)(dq + (tokbase + t0 + rg * 16 + lr) * 512 + hd * 64 + lq * 8);
            qf[rg][1] = *(const bf16x8*)(dq + (tokbase + t0 + rg * 16 + lr) * 512 + hd * 64 + 32 + lq * 8);
        }
        f32x4 oacc[2][4];
#pragma unroll
        for (int rg = 0; rg < 2; rg++)
#pragma unroll
            for (int n = 0; n < 4; n++) oacc[rg][n] = f32x4{0.f, 0.f, 0.f, 0.f};
        float m_run[2] = {-1e30f, -1e30f}, l_run[2] = {0.f, 0.f};
        const int ntile = (t0 + 31) / 64 + 1;
        const int tidc = opaque_tid();
        const int gg0 = tidc >> 9, gg1 = (tidc + 512) >> 9;
        const int sr = (tidc >> 3) & 63, scn = (tidc & 7) * 8;
        const bf16_t* kg0 = dk + (tokbase + sr) * 128 + gg0 * 64 + scn;
        const bf16_t* kg1 = dk + (tokbase + sr) * 128 + gg1 * 64 + scn;
        const bf16_t* vg0 = dvT + ((size_t)((b * 2 + gg0) * 64 + sr)) * 2048 + scn;
        const bf16_t* vg1 = dvT + ((size_t)((b * 2 + gg1) * 64 + sr)) * 2048 + scn;
        {
            const uint4 pk0 = *(const uint4*)kg0, pk1 = *(const uint4*)kg1, pv0 = *(const uint4*)vg0, pv1 = *(const uint4*)vg1;
            bf16_t* Vn = KB0 + 2 * 64 * LDP;
            *(uint4*)(KB0 + (gg0 * 64 + sr) * LDP + scn) = pk0;
            *(uint4*)(KB0 + (gg1 * 64 + sr) * LDP + scn) = pk1;
            *(uint4*)(Vn + (gg0 * 64 + sr) * LDP + scn) = pv0;
            *(uint4*)(Vn + (gg1 * 64 + sr) * LDP + scn) = pv1;
        }
        __builtin_amdgcn_s_waitcnt(0x0F70);
        __syncthreads();
        for (int kt = 0; kt < ntile; kt++) {
            const int j0 = kt * 64;
            uint4 pk0, pk1, pv0, pv1;
            if (kt + 1 < ntile) {
                pk0 = *(const uint4*)(kg0 + (size_t)(j0 + 64) * 128); pk1 = *(const uint4*)(kg1 + (size_t)(j0 + 64) * 128);
                pv0 = *(const uint4*)(vg0 + j0 + 64); pv1 = *(const uint4*)(vg1 + j0 + 64);
            }
            const bf16_t* Kc = (kt & 1) ? KB1 : KB0;
            const bf16_t* Vc = Kc + 2 * 64 * LDP;
            f32x4 lg[2][4];
#pragma unroll
            for (int rg = 0; rg < 2; rg++)
#pragma unroll
                for (int n = 0; n < 4; n++) lg[rg][n] = f32x4{0.f, 0.f, 0.f, 0.f};
#pragma unroll
            for (int ks = 0; ks < 2; ks++)
#pragma unroll
                for (int n = 0; n < 4; n++) {
                    const bf16x8 kf = *(const bf16x8*)(Kc + (g * 64 + n * 16 + lr) * LDP + ks * 32 + lq * 8);
                    lg[0][n] = mfma16(kf, qf[0][ks], lg[0][n]);
                    lg[1][n] = mfma16(kf, qf[1][ks], lg[1][n]);
                }
            bf16x8 pf[2][2];
#pragma unroll
            for (int rg = 0; rg < 2; rg++) {
                const unsigned* selrow = Sel + (rg * 16 + lr) * 65 + kt * 2;
                const unsigned w0 = selrow[0], w1 = selrow[1];
                float mx = -2e30f;
#pragma unroll
                for (int n = 0; n < 4; n++) {
                    const int wsh = (int)(((n < 2) ? w0 : w1) >> ((n & 1) * 16 + lq * 4));
#pragma unroll
                    for (int r = 0; r < 4; r++) {
                        const int msk = __builtin_amdgcn_sbfe(wsh, r, 1);
                        lg[rg][n][r] = __int_as_float((__float_as_int(lg[rg][n][r]) & msk) | (__float_as_int(-2e30f) & ~msk));
                        mx = fmaxf(mx, lg[rg][n][r]);
                    }
                }
                mx = lq_max(mx);
                const float m_new = fmaxf(m_run[rg], mx);
                const float alpha = __builtin_amdgcn_exp2f(m_run[rg] - m_new);
                float psum = 0.f;
#pragma unroll
                for (int n = 0; n < 4; n++)
#pragma unroll
                    for (int r = 0; r < 4; r++) { lg[rg][n][r] = __builtin_amdgcn_exp2f(lg[rg][n][r] - m_new); psum += lg[rg][n][r]; }
                psum = lq_sum(psum);
                l_run[rg] = l_run[rg] * alpha + psum;
                m_run[rg] = m_new;
#pragma unroll
                for (int n = 0; n < 4; n++) oacc[rg][n] = oacc[rg][n] * alpha;
#pragma unroll
                for (int ks = 0; ks < 2; ks++) {
                    const uint4 pu = make_uint4(pack2(lg[rg][2 * ks][0], lg[rg][2 * ks][1]), pack2(lg[rg][2 * ks][2], lg[rg][2 * ks][3]),
                                                pack2(lg[rg][2 * ks + 1][0], lg[rg][2 * ks + 1][1]), pack2(lg[rg][2 * ks + 1][2], lg[rg][2 * ks + 1][3]));
                    pf[rg][ks] = __builtin_bit_cast(bf16x8, pu);
                }
            }
#pragma unroll
            for (int ks = 0; ks < 2; ks++)
#pragma unroll
                for (int n = 0; n < 4; n++) {
                    const bf16_t* vrow = Vc + (g * 64 + n * 16 + lr) * LDP + ks * 32 + lq * 4;
                    const uint2 v0 = *(const uint2*)(vrow), v1 = *(const uint2*)(vrow + 16);
                    const bf16x8 vf = __builtin_bit_cast(bf16x8, make_uint4(v0.x, v0.y, v1.x, v1.y));
                    oacc[0][n] = mfma16(vf, pf[0][ks], oacc[0][n]);
                    oacc[1][n] = mfma16(vf, pf[1][ks], oacc[1][n]);
                }
            if (kt + 1 < ntile) {
                bf16_t* Kn = (kt & 1) ? KB0 : KB1;
                bf16_t* Vn = Kn + 2 * 64 * LDP;
                *(uint4*)(Kn + (gg0 * 64 + sr) * LDP + scn) = pk0;
                *(uint4*)(Kn + (gg1 * 64 + sr) * LDP + scn) = pk1;
                *(uint4*)(Vn + (gg0 * 64 + sr) * LDP + scn) = pv0;
                *(uint4*)(Vn + (gg1 * 64 + sr) * LDP + scn) = pv1;
            }
            __syncthreads();
        }
#pragma unroll
        for (int rg = 0; rg < 2; rg++) {
            const float inv = 1.f / l_run[rg];
#pragma unroll
            for (int n = 0; n < 4; n++)
                *(uint2*)(odsa + (tokbase + t0 + rg * 16 + lr) * 512 + hd * 64 + n * 16 + lq * 4) = pack4(oacc[rg][n] * inv);
        }
    }
}

DEVINL void phase_mixers(const KParams& p, unsigned char* lds) {
    const int G = gridDim.x;
    for (int r = 0; r * G < 512; r++) {
        const int idx = r * G + ((r & 1) ? (G - 1 - (int)blockIdx.x) : (int)blockIdx.x);
        if (idx < 512) dsa_unit(p, lds, idx & 7, 63 - (idx >> 3));
    }
    __syncthreads();
    for (int u = blockIdx.x; u < 1024; u += G) {
        const int qt = 31 - (u >> 5), rest = u & 31;
        for (int reps = 0; reps < REP_SB; reps++) sb_unit(p, lds, rest >> 2, rest & 3, qt);
    }
}

DEVINL void phase_merge(const KParams& p, unsigned char* lds) {
    unsigned char* ws = p.ws;
    static_assert(OFF_ODSA == OFF_OSB + 16 * MB && OFF_WTDSA == OFF_WTSB + 1 * MB, "the stacked operands must be contiguous");
    pg8::Gemm g{(const bf16_t*)(ws + OFF_OSB), (const bf16_t*)(ws + OFF_WTSB), 32768, 2048, 512};
    MergeOrder S; S.S.init(16384, 1024, (int)gridDim.x, (int)blockIdx.x);
    EpiMerge2 E{(const bf16_t*)(ws + OFF_GATES), (bf16_t*)(ws + OFF_MERGED)};
    pg8::gemm_phase<EpiMerge2, MergeOrder, true, true>((lds_ptr_t)lds, g, S, E);
}

DEVINL void phase_resid(const KParams& p, unsigned char* lds, const bf16_t* A, int K, const bf16_t* Wt, const float* res32, float* rowss) {
    if (res32) { EpiResid<true> E{res32, (bf16_t*)(p.ws + OFF_HB), rowss}; run_gemm<EpiResid<true>, true>(lds, A, Wt, 16384, 1024, K, E); }
    else { EpiResid<false> E{nullptr, (bf16_t*)(p.ws + OFF_HB), rowss}; run_gemm<EpiResid<false>, true>(lds, A, Wt, 16384, 1024, K, E); }
}

DEVINL void phase_down_final(const KParams& p, unsigned char* lds) {
    unsigned char* ws = p.ws;
    EpiFinal E{(const bf16_t*)(ws + OFF_HB), p.out, p.in[17], (float*)(ws + OFF_BAR + 32768), (unsigned*)(ws + OFF_BAR + 16384)};
    run_gemm<EpiFinal, false>(lds, (const bf16_t*)(ws + OFF_HDN), (const bf16_t*)(ws + OFF_WTDOWN), 16384, 1024, 4096, E);
}

DEVINL void phase_cq(const KParams& p, unsigned char* lds) {
    unsigned char* ws = p.ws;
    EpiCq E{(const float*)(ws + OFF_ROWSS), (bf16_t*)(ws + OFF_QC)};
    run_gemm<EpiCq, true>(lds, (const bf16_t*)(ws + OFF_HB), (const bf16_t*)(ws + OFF_WTCQ), 16384, 512, 1024, E);
    EpiMemKV E2{(bf16_t*)(ws + OFF_KMEM), (bf16_t*)(ws + OFF_VMEMT)};
    const int G = gridDim.x;
    int c = (int)blockIdx.x;
    if (G >= 160) c = (c >= 128) ? c - 128 : (1 << 20);
    run_gemm<EpiMemKV, true>(lds, (const bf16_t*)(ws + OFF_MEMN), (const bf16_t*)(ws + OFF_WTCKV), 2048, 1024, 1024, E2, c);
    const int first = (G >= 192) ? 160 : 0;
    float* tile = (float*)lds;
    transpose_job(p.in[13], 512, 1024, 1024, (bf16_t*)(ws + OFF_WTCO), nullptr, tile, false, 0, first);
    transpose_job(p.in[15], 1024, 4096, 4096, (bf16_t*)(ws + OFF_WTUP), p.in[14], tile, false, 0, first);
    transpose_job(p.in[16], 4096, 1024, 1024, (bf16_t*)(ws + OFF_WTDOWN), nullptr, tile, false, 0, first);
}

DEVINL void cross_unit(const KParams& p, unsigned char* lds, int rt2, int h) {
    unsigned char* ws = p.ws;
    const bf16_t* qc = (const bf16_t*)(ws + OFF_QC); const bf16_t* kmem = (const bf16_t*)(ws + OFF_KMEM); const bf16_t* vmemT = (const bf16_t*)(ws + OFF_VMEMT);
    bf16_t* oc = (bf16_t*)(ws + OFF_OC);
    bf16_t* Kl = (bf16_t*)lds;
    bf16_t* Vl = Kl + 256 * 136;
    const int tid = opaque_tid(), lane = tid & 63, wave = __builtin_amdgcn_readfirstlane(tid >> 6), lr = lane & 15, lq = lane >> 4;
    const int b = (rt2 * 256) >> 11;
    bf16x8 qfa[2][4];
#pragma unroll
    for (int half = 0; half < 2; half++) {
        const bf16_t* qrow = qc + (size_t)(rt2 * 256 + half * 128 + wave * 16 + lr) * 512 + h * 128 + lq * 8;
#pragma unroll
        for (int ks = 0; ks < 4; ks++) qfa[half][ks] = *(const bf16x8*)(qrow + ks * 32);
    }
#pragma unroll
    for (int i = 0; i < 8; i++) {
        const int id = tid + i * 512, r = id >> 4, c = (id & 15) * 8;
        *(uint4*)(Kl + r * 136 + c) = *(const uint4*)(kmem + (size_t)(b * 256 + r) * 512 + h * 128 + c);
    }
#pragma unroll
    for (int i = 0; i < 8; i++) {
        const int id = tid + i * 512, r = id >> 5, c = (id & 31) * 8;
        *(uint4*)(Vl + r * 264 + c) = *(const uint4*)(vmemT + ((size_t)((b * 4 + h) * 128 + r)) * 256 + c);
    }
    __syncthreads();
#pragma unroll
    for (int half = 0; half < 2; half++) {
    const int row0 = rt2 * 256 + half * 128;
    bf16x8 qf[4];
#pragma unroll
    for (int ks = 0; ks < 4; ks++) qf[ks] = qfa[half][ks];
    f32x4 s[16];
#pragma unroll
    for (int n = 0; n < 16; n++) s[n] = f32x4{0.f, 0.f, 0.f, 0.f};
#pragma unroll
    for (int ks = 0; ks < 4; ks++)
#pragma unroll
        for (int n = 0; n < 16; n++) {
            const bf16x8 kf = *(const bf16x8*)(Kl + (n * 16 + lr) * 136 + ks * 32 + lq * 8);
            s[n] = mfma16(kf, qf[ks], s[n]);
            if ((n & 7) == 7) __builtin_amdgcn_sched_barrier(0);
        }
    float mx = -3e38f;
#pragma unroll
    for (int n = 0; n < 16; n++) mx = fmaxf(mx, fmaxf(fmaxf(s[n][0], s[n][1]), fmaxf(s[n][2], s[n][3])));
    mx = lq_max(mx);
    float sum = 0.f;
#pragma unroll
    for (int n = 0; n < 16; n++)
#pragma unroll
        for (int r = 0; r < 4; r++) { s[n][r] = __builtin_amdgcn_exp2f(s[n][r] - mx); sum += s[n][r]; }
    sum = lq_sum(sum);
    f32x4 o[8];
#pragma unroll
    for (int n = 0; n < 8; n++) o[n] = f32x4{0.f, 0.f, 0.f, 0.f};
#pragma unroll
    for (int ks = 0; ks < 8; ks++) {
        const uint4 pu = make_uint4(pack2(s[2 * ks][0], s[2 * ks][1]), pack2(s[2 * ks][2], s[2 * ks][3]),
                                    pack2(s[2 * ks + 1][0], s[2 * ks + 1][1]), pack2(s[2 * ks + 1][2], s[2 * ks + 1][3]));
        const bf16x8 pf = __builtin_bit_cast(bf16x8, pu);
#pragma unroll
        for (int n = 0; n < 8; n++) {
            const bf16_t* vrow = Vl + (n * 16 + lr) * 264 + ks * 32 + lq * 4;
            const uint2 v0 = *(const uint2*)(vrow), v1 = *(const uint2*)(vrow + 16);
            const bf16x8 vf = __builtin_bit_cast(bf16x8, make_uint4(v0.x, v0.y, v1.x, v1.y));
            o[n] = mfma16(vf, pf, o[n]);
        }
        __builtin_amdgcn_sched_barrier(0);
    }
    const float inv = __builtin_amdgcn_rcpf(sum);
#pragma unroll
    for (int n = 0; n < 8; n++)
        *(uint2*)(oc + (size_t)(row0 + wave * 16 + lr) * 512 + h * 128 + n * 16 + lq * 4) = pack4(o[n] * inv);
    }
    __syncthreads();
}

DEVINL void phase_up(const KParams& p, unsigned char* lds) {
    unsigned char* ws = p.ws;
    EpiUp E{(const float*)(ws + OFF_ROWSS) + 16384, (bf16_t*)(ws + OFF_HDN)};
    run_gemm<EpiUp, true>(lds, (const bf16_t*)(ws + OFF_HB), (const bf16_t*)(ws + OFF_WTUP), 16384, 4096, 1024, E);
}

DEVINL void phase_final(const KParams& p) {
    const bf16_t* hb = (const bf16_t*)(p.ws + OFF_HB);
    const float* rowss3 = (const float*)(p.ws + OFF_ROWSS) + 32768;
    const float* g = p.in[17];
    for (int i = blockIdx.x * NTHREADS + threadIdx.x; i < 16384 * 128; i += gridDim.x * NTHREADS) {
        const int row = i >> 7, col = (i & 127) * 8;
        const float rs = rsqrtf(rowss3[row] * (1.f / 1024.f) + EPS);
        const uint4 o = *(const uint4*)(hb + (size_t)row * 1024 + col);
        const float4 g0 = *(const float4*)(g + col), g1 = *(const float4*)(g + col + 4);
        float* dst = p.out + (size_t)row * 1024 + col;
        *(float4*)dst = make_float4(bf2f(o.x & 0xffffu) * rs * g0.x, bf2f(o.x >> 16) * rs * g0.y, bf2f(o.y & 0xffffu) * rs * g0.z, bf2f(o.y >> 16) * rs * g0.w);
        *(float4*)(dst + 4) = make_float4(bf2f(o.z & 0xffffu) * rs * g1.x, bf2f(o.z >> 16) * rs * g1.y, bf2f(o.w & 0xffffu) * rs * g1.z, bf2f(o.w >> 16) * rs * g1.w);
    }
}

__global__ void __launch_bounds__(NTHREADS, 2) mega_fwd(KParams p) {
    extern __shared__ __attribute__((aligned(16))) unsigned char lds[];
    cg::grid_group grid = cg::this_grid();
    unsigned char* ws = p.ws;
    float* rowss = (float*)(ws + OFF_ROWSS);
    if (p.ph_lo > p.ph_hi) grid.sync();
    volatile LAS unsigned* xst = (volatile LAS unsigned*)((lds_ptr_t)lds + LDS_BYTES - 16);
    if (threadIdx.x < 4) xst[threadIdx.x] = 0u;
    __syncthreads();
    XcdBarrier xb = xcd_barrier_post((unsigned*)(ws + OFF_BAR), xst);
#ifndef PROBE_DUP
#define PROBE_DUP -1
#endif
#define RUN_PHASE(k, body) if (p.ph_lo <= (k) && (k) < p.ph_hi) { body; if ((k) == PROBE_DUP) { xcd_barrier(xb); body; } if ((k) + 1 < p.ph_hi) xcd_barrier(xb); }
    RUN_PHASE(0, phase_prep(p, lds))
    RUN_PHASE(1, phase_inproj(p, lds))
    RUN_PHASE(2, phase_mixers(p, lds))
    RUN_PHASE(3, phase_merge(p, lds))
    RUN_PHASE(4, phase_resid(p, lds, (const bf16_t*)(ws + OFF_MERGED), 1024, (const bf16_t*)(ws + OFF_WTOUT), p.in[0], rowss))
    RUN_PHASE(5, phase_cq(p, lds))
    RUN_PHASE(6, for (int u = blockIdx.x; u < 256; u += gridDim.x) cross_unit(p, lds, u >> 2, u & 3))
    RUN_PHASE(7, phase_resid(p, lds, (const bf16_t*)(ws + OFF_OC), 512, (const bf16_t*)(ws + OFF_WTCO), nullptr, rowss + 16384))
    RUN_PHASE(8, phase_up(p, lds))
    if (gridDim.x == 256) {
        if (p.ph_lo <= 9 && 9 < p.ph_hi) phase_down_final(p, lds);
    } else {
        RUN_PHASE(9, phase_resid(p, lds, (const bf16_t*)(ws + OFF_HDN), 4096, (const bf16_t*)(ws + OFF_WTDOWN), nullptr, rowss + 32768))
        RUN_PHASE(10, phase_final(p))
    }
}

extern "C" void kernel_launch(void* const* d_in, const int* in_sizes, int n_in, void* d_out, int out_size, void* d_ws, size_t ws_size, hipStream_t stream) {
    static int grid = 0;
    if (grid == 0) {
        if (n_in != 18 || out_size != 16384 * 1024 || ws_size < WS_END) {
            fprintf(stderr, "kernel_launch: unexpected problem (n_in %d, out %d, ws %zu, need %zu)\n", n_in, out_size, ws_size, (size_t)WS_END);
            grid = -1; return;
        }
        int dev = 0, cus = 0, per_cu = 0;
        hipGetDevice(&dev);
        hipDeviceGetAttribute(&cus, hipDeviceAttributeMultiprocessorCount, dev);
        if (hipFuncSetAttribute((const void*)mega_fwd, hipFuncAttributeMaxDynamicSharedMemorySize, LDS_BYTES) != hipSuccess) {
            fprintf(stderr, "kernel_launch: hipFuncSetAttribute failed\n"); grid = -1; return;
        }
        if (hipOccupancyMaxActiveBlocksPerMultiprocessor(&per_cu, (const void*)mega_fwd, NTHREADS, LDS_BYTES) != hipSuccess || per_cu < 1) {
            fprintf(stderr, "kernel_launch: occupancy query says %d blocks per CU\n", per_cu);
            per_cu = 1;
        }
        (void)hipGetLastError();
        grid = cus;
    }
    if (grid < 0) return;
    if (hipMemsetAsync((unsigned char*)d_ws + OFF_BAR, 0, 16384 + 256, stream) != hipSuccess) { fprintf(stderr, "kernel_launch: memset of the barrier words failed\n"); return; }
    KParams p{};
    for (int i = 0; i < 18; i++) p.in[i] = (const float*)d_in[i];
    p.out = (float*)d_out;
    p.ws = (unsigned char*)d_ws;
    p.ph_lo = 0; p.ph_hi = 11;
    void* args[] = {&p};
    hipError_t e = hipLaunchCooperativeKernel((const void*)mega_fwd, dim3(grid), dim3(NTHREADS), args, LDS_BYTES, stream);
    if (e != hipSuccess) fprintf(stderr, "kernel_launch: cooperative launch failed: %s (grid %d)\n", hipGetErrorString(e), grid);
}
```

```cpp
#include <hip/hip_runtime.h>
#include <hip/hip_cooperative_groups.h>
#include <cstdio>
#include <cstdint>
namespace cg = cooperative_groups;

#define DEVINL __device__ __forceinline__
typedef unsigned short bf16_t;
typedef short bf16x8 __attribute__((ext_vector_type(8)));
typedef float f32x4 __attribute__((ext_vector_type(4)));

constexpr int NTHREADS = 512;
constexpr int LDS_BYTES = 159744;
constexpr float EPS = 1e-6f;
constexpr size_t MB = 1u << 20;

constexpr size_t OFF_SBQ = 0 * MB, OFF_SBK = 16 * MB, OFF_SBVT = 32 * MB, OFF_DQ = 48 * MB, OFF_DK = 64 * MB, OFF_DVT = 68 * MB,
                 OFF_IQ = 72 * MB, OFF_IK = 88 * MB, OFF_GATES = 90 * MB, OFF_U0 = 154 * MB, OFF_MEMN = 186 * MB;
constexpr size_t OFF_MERGED = 0 * MB, OFF_HB = 32 * MB, OFF_QC = 72 * MB, OFF_OC = 90 * MB, OFF_OSB = 154 * MB, OFF_ODSA = 170 * MB, OFF_HDN = 64 * MB;
constexpr size_t OFF_WT1 = 192 * MB, OFF_WTSB = 202 * MB, OFF_WTDSA = 203 * MB, OFF_WTOUT = 204 * MB, OFF_WTCQ = 206 * MB, OFF_WTCKV = 207 * MB,
                 OFF_WTCO = 209 * MB, OFF_WTUP = 210 * MB, OFF_WTDOWN = 218 * MB, OFF_KMEM = 226 * MB, OFF_VMEMT = 228 * MB,
                 OFF_ROPEC = 230 * MB, OFF_ROPES = 230 * MB + 256 * 1024, OFF_IW = 230 * MB + 512 * 1024, OFF_ROWSS = 231 * MB, OFF_BAR = 232 * MB, WS_END = 233 * MB;
constexpr int N1 = 4992;
constexpr int N1P = 5120;
constexpr int GATE0 = 2944;

struct KParams {
    const float* in[18];
    float* out;
    unsigned char* ws;
    int ph_lo, ph_hi;
};

typedef float f32x2_t __attribute__((ext_vector_type(2))); typedef __bf16 bf16x2_t __attribute__((ext_vector_type(2)));
DEVINL unsigned cvtpk(float lo, float hi) { f32x2_t v = {lo, hi}; bf16x2_t b = __builtin_convertvector(v, bf16x2_t); return __builtin_bit_cast(unsigned, b); }
DEVINL bf16_t f2bf(float f) { return (bf16_t)(cvtpk(f, 0.f) & 0xffffu); }
DEVINL float bf2f(unsigned h) { return __uint_as_float(h << 16); }
DEVINL unsigned pack2(float a, float b) { return cvtpk(a, b); }
DEVINL uint2 pack4(f32x4 v) { return make_uint2(pack2(v[0], v[1]), pack2(v[2], v[3])); }
DEVINL float wave_sum(float v) {
    v += __shfl_xor(v, 32); v += __shfl_xor(v, 16); v += __shfl_xor(v, 8); v += __shfl_xor(v, 4); v += __shfl_xor(v, 2); v += __shfl_xor(v, 1);
    return v;
}
DEVINL int wave_sum_i(int v) {
    v += __shfl_xor(v, 32); v += __shfl_xor(v, 16); v += __shfl_xor(v, 8); v += __shfl_xor(v, 4); v += __shfl_xor(v, 2); v += __shfl_xor(v, 1);
    return v;
}
DEVINL float wave_min(float v) {
    v = fminf(v, __shfl_xor(v, 32)); v = fminf(v, __shfl_xor(v, 16)); v = fminf(v, __shfl_xor(v, 8));
    v = fminf(v, __shfl_xor(v, 4)); v = fminf(v, __shfl_xor(v, 2)); v = fminf(v, __shfl_xor(v, 1));
    return v;
}
DEVINL f32x4 mfma16(bf16x8 a, bf16x8 b, f32x4 c) { return __builtin_amdgcn_mfma_f32_16x16x32_bf16(a, b, c, 0, 0, 0); }
DEVINL float softplus_f(float z) { return fmaxf(z, 0.f) + __logf(1.f + __expf(-fabsf(z))); }
DEVINL unsigned short f2key(float s) {
    _Float16 hf = (_Float16)s;
    unsigned short bits = __builtin_bit_cast(unsigned short, hf);
    return (bits & 0x8000u) ? (unsigned short)(~bits) : (unsigned short)(bits | 0x8000u);
}

DEVINL int perm256(int l) { const int w = l & 255, j = w >> 6, d = w & 63; return (l & ~255) + (d >> 5) * 128 + j * 32 + (d & 31); }
DEVINL void transpose_job(const float* __restrict__ src, int K, int N, int Npad, bf16_t* __restrict__ dst, const float* __restrict__ kscale, float* tile, bool permute = false, int lbase = 0, int first_blk = 0) {
    const int tid = threadIdx.x;
    const int nkt = K / 64, nnt = Npad / 64, ntile = nkt * nnt;
    if ((int)blockIdx.x < first_blk) return;
    const int stride = (int)gridDim.x - first_blk;
    int t = (int)blockIdx.x - first_blk;
    if (t >= ntile) return;
    const int r0 = tid >> 4, c4 = (tid & 15) * 4;
    float4 va, vb; float sa = 1.f, sb = 1.f;
    auto load = [&](int tt) {
        const int tk = tt % nkt, tn = tt / nkt;
        const int k = tk * 64 + r0, n = tn * 64 + c4;
        va = make_float4(0.f, 0.f, 0.f, 0.f); vb = va;
        if (n < N) { va = *(const float4*)(src + (size_t)k * N + n); vb = *(const float4*)(src + (size_t)(k + 32) * N + n); }
        if (kscale) { sa = kscale[k]; sb = kscale[k + 32]; }
    };
    load(t);
    for (; t < ntile; t += stride) {
        const int tk = t % nkt, tn = t / nkt;
        tile[r0 * 65 + c4 + 0] = va.x * sa; tile[r0 * 65 + c4 + 1] = va.y * sa; tile[r0 * 65 + c4 + 2] = va.z * sa; tile[r0 * 65 + c4 + 3] = va.w * sa;
        tile[(r0 + 32) * 65 + c4 + 0] = vb.x * sb; tile[(r0 + 32) * 65 + c4 + 1] = vb.y * sb; tile[(r0 + 32) * 65 + c4 + 2] = vb.z * sb; tile[(r0 + 32) * 65 + c4 + 3] = vb.w * sb;
        __syncthreads();
        if (t + stride < ntile) load(t + stride);
        {
            const int nr = tid >> 3, kc = (tid & 7) * 8;
            const int n = tn * 64 + nr;
            uint4 o;
            o.x = pack2(tile[(kc + 0) * 65 + nr], tile[(kc + 1) * 65 + nr]);
            o.y = pack2(tile[(kc + 2) * 65 + nr], tile[(kc + 3) * 65 + nr]);
            o.z = pack2(tile[(kc + 4) * 65 + nr], tile[(kc + 5) * 65 + nr]);
            o.w = pack2(tile[(kc + 6) * 65 + nr], tile[(kc + 7) * 65 + nr]);
            const int drow = permute ? perm256(lbase + n) : n;
            *(uint4*)(dst + (size_t)drow * K + tk * 64 + kc) = o;
        }
        __syncthreads();
    }
}

DEVINL void rmsnorm_row_bf16(const float* __restrict__ src, const float* __restrict__ g, bf16_t* __restrict__ dst, int lane) {
    float4 v[4];
    float ss = 0.f;
#pragma unroll
    for (int i = 0; i < 4; i++) {
        v[i] = *(const float4*)(src + i * 256 + lane * 4);
        ss += v[i].x * v[i].x + v[i].y * v[i].y + v[i].z * v[i].z + v[i].w * v[i].w;
    }
    ss = wave_sum(ss);
    const float rs = rsqrtf(ss * (1.f / 1024.f) + EPS);
#pragma unroll
    for (int i = 0; i < 4; i++) {
        const float4 g4 = *(const float4*)(g + i * 256 + lane * 4);
        uint2 o = make_uint2(pack2(v[i].x * rs * g4.x, v[i].y * rs * g4.y), pack2(v[i].z * rs * g4.z, v[i].w * rs * g4.w));
        *(uint2*)(dst + i * 256 + lane * 4) = o;
    }
}

DEVINL void phase_prep(const KParams& p, unsigned char* lds) {
    float* tile = (float*)lds;
    unsigned char* ws = p.ws;
    bf16_t* wt1 = (bf16_t*)(ws + OFF_WT1);
    transpose_job(p.in[3], 1024, 2888, 2944, wt1, nullptr, tile, true, 0);
    transpose_job(p.in[6], 1024, 2048, 2176, wt1, nullptr, tile, true, GATE0);
    transpose_job(p.in[4], 512, 1024, 1024, (bf16_t*)(ws + OFF_WTSB), nullptr, tile);
    transpose_job(p.in[5], 512, 1024, 1024, (bf16_t*)(ws + OFF_WTDSA), nullptr, tile);
    transpose_job(p.in[8], 1024, 1024, 1024, (bf16_t*)(ws + OFF_WTOUT), nullptr, tile);
    transpose_job(p.in[11], 1024, 512, 512, (bf16_t*)(ws + OFF_WTCQ), p.in[9], tile);
    transpose_job(p.in[12], 1024, 1024, 1024, (bf16_t*)(ws + OFF_WTCKV), nullptr, tile);
    const int lane = threadIdx.x & 63, wave = threadIdx.x >> 6;
    {
        const int nw = gridDim.x * 8, w0 = blockIdx.x * 8 + wave;
        for (int r = w0; r < 16384 + 2048; r += 4 * nw) {
            float4 v[4][4];
#pragma unroll
            for (int j = 0; j < 4; j++) {
                const int rr = r + j * nw;
                if (rr < 16384 + 2048) {
                    const float* src = (rr < 16384) ? p.in[0] + (size_t)rr * 1024 : p.in[1] + (size_t)(rr - 16384) * 1024;
#pragma unroll
                    for (int i = 0; i < 4; i++) v[j][i] = *(const float4*)(src + i * 256 + lane * 4);
                }
            }
#pragma unroll
            for (int j = 0; j < 4; j++) {
                const int rr = r + j * nw;
                if (rr < 16384 + 2048) {
                    const float* g = (rr < 16384) ? p.in[2] : p.in[10];
                    bf16_t* dst = (rr < 16384) ? (bf16_t*)(ws + OFF_U0) + (size_t)rr * 1024 : (bf16_t*)(ws + OFF_MEMN) + (size_t)(rr - 16384) * 1024;
                    float ss = 0.f;
#pragma unroll
                    for (int i = 0; i < 4; i++) ss += v[j][i].x * v[j][i].x + v[j][i].y * v[j][i].y + v[j][i].z * v[j][i].z + v[j][i].w * v[j][i].w;
                    ss = wave_sum(ss);
                    const float rs = rsqrtf(ss * (1.f / 1024.f) + EPS);
#pragma unroll
                    for (int i = 0; i < 4; i++) {
                        const float4 g4 = *(const float4*)(g + i * 256 + lane * 4);
                        *(uint2*)(dst + i * 256 + lane * 4) = make_uint2(pack2(v[j][i].x * rs * g4.x, v[j][i].y * rs * g4.y), pack2(v[j][i].z * rs * g4.z, v[j][i].w * rs * g4.w));
                    }
                }
            }
        }
    }
    float* cosT = (float*)(ws + OFF_ROPEC);
    float* sinT = (float*)(ws + OFF_ROPES);
    float* rowss = (float*)(ws + OFF_ROWSS);
    for (int i = blockIdx.x * NTHREADS + threadIdx.x; i < 65536; i += gridDim.x * NTHREADS) {
        const int pos = i >> 5, fi = i & 31;
        const float inv = exp2f(-(float)fi * 0.41524101186092029f);
        const float ang = (float)pos * inv;
        const double rev = (double)ang * 0.15915494309189535;
        const float fr = (float)(rev - floor(rev));
        cosT[i] = __builtin_amdgcn_cosf(fr);
        sinT[i] = __builtin_amdgcn_sinf(fr);
        if (i < 49152) rowss[i] = 0.f;
    }
}

namespace pg8 {
#define PG8_LAS __attribute__((address_space(3)))
typedef unsigned short bf16_t;
typedef short bf16x8 __attribute__((ext_vector_type(8)));
typedef float f32x4 __attribute__((ext_vector_type(4)));
typedef unsigned u32x4 __attribute__((ext_vector_type(4)));
constexpr int BM = 256, BK = 64, HALF = 128, HTB = HALF * BK * 2  , STAGE_BYTES = 8 * HTB, NXCD = 8, WGM = 4;

__host__ __device__ __forceinline__ int lds_byte(int r, int c) { const int st = (r >> 4) * 2 + (c >> 5), rr = r & 15, cc = c & 31, ob = rr * 64 + cc * 2; return st * 1024 + (ob ^ (((ob >> 9) & 1) << 5)); }
__host__ __device__ __forceinline__ void stage_rc(int b, int& R, int& C) { const int st = b / 1024, sb = b % 1024, swz = sb ^ (((sb >> 9) & 1) << 5); R = (st >> 1) * 16 + swz / 64; C = (st & 1) * 32 + (swz % 64) / 2; }
__host__ __device__ __forceinline__ int perm32(int rho) { const int n = rho >> 4, i = rho & 15; return 8 * (i >> 2) + 4 * n + (i & 3); }

struct Unit { int pm, pn; };
struct Gemm { const bf16_t* A; const bf16_t* Bt; int M, N, K; };

struct StaticOrder {
    int nM, nN, nwg, G, c;
    __host__ __device__ void init(int M, int N, int G_, int c_) { nM = M / BM; nN = N / BM; nwg = nM * nN; G = G_; c = c_; }
    __host__ __device__ bool next(int i, Unit& u) const {
        const long L = (long)i * G + c; if (L >= nwg) return false;
        int wgid = (int)L; { const int q = nwg / NXCD, r = nwg % NXCD, xcd = wgid % NXCD, off = wgid / NXCD; wgid = (xcd < r ? xcd * (q + 1) : r * (q + 1) + (xcd - r) * q) + off; }
        const int nig = WGM * nN, gid = wgid / nig, fm = gid * WGM, gsz = (nM - fm) < WGM ? (nM - fm) : WGM;
        u.pm = fm + ((wgid % nig) % gsz); u.pn = (wgid % nig) / gsz; return true;
    }
    __device__ __forceinline__ void a_ready(const Unit&) const {}
    __device__ __forceinline__ void done(const Unit&) const {}
};
template <class Epi, class Sched, bool ALIGN_EPI = false, bool SP2 = false>
__device__ __forceinline__ void gemm_phase(PG8_LAS unsigned char* lds, const Gemm g, const Sched& S, const Epi& E) {
    const int tid = threadIdx.x, wid = __builtin_amdgcn_readfirstlane(tid >> 6), lane = tid & 63, wr = wid >> 2, wc = wid & 3, fr = lane & 15, fq = lane >> 4;
    const int K = g.K, nt = K / BK;
    unsigned voffA[2], voffB[2];
#pragma unroll
    for (int i = 0; i < 2; ++i) { int R, C; stage_rc(tid * 16 + i * 8192, R, C); const int Rb = Epi::PERM ? ((R & ~31) + perm32(R & 31)) : R;
        voffA[i] = (unsigned)(R * K + C) * 2u; voffB[i] = (unsigned)(Rb * K + C) * 2u; }
    const size_t kstep = (size_t)(BK * 2);
    const size_t hstep = (size_t)HALF * K * 2;
    const size_t tstep = 2 * hstep;
    const unsigned ldsw = (unsigned)wid * 1024u;
    const int aoff = lds_byte(wr * 64 + fr, fq * 8), boff = lds_byte(wc * 32 + fr, fq * 8);
#define PG8_SA(b, h) (((b) * 2 + (h)) * HTB)
#define PG8_SB(b, h) ((4 + (b) * 2 + (h)) * HTB)
#define PG8_STAGE(bufoff, gbase, voff) do { _Pragma("unroll") for (int _i = 0; _i < 2; ++_i) \
        __builtin_amdgcn_global_load_lds((const unsigned*)((const char*)(gbase) + (voff)[_i]), (PG8_LAS unsigned*)(lds + (bufoff) + ldsw + _i * 8192), 16, 0, 0); } while (0)
#define PG8_LDA(dst, b, h) do { _Pragma("unroll") for (int m = 0; m < 4; ++m) _Pragma("unroll") for (int k = 0; k < 2; ++k) dst[m][k] = *(const PG8_LAS bf16x8*)(lds + PG8_SA(b, h) + aoff + m * 2048 + k * 1024); } while (0)
#define PG8_LDB(dst, b, h) do { _Pragma("unroll") for (int n = 0; n < 2; ++n) _Pragma("unroll") for (int k = 0; k < 2; ++k) dst[n][k] = *(const PG8_LAS bf16x8*)(lds + PG8_SB(b, h) + boff + n * 2048 + k * 1024); } while (0)
#define PG8_MMA(ai, bj, At, Bt) do { __builtin_amdgcn_s_setprio(1); _Pragma("unroll") for (int m = 0; m < 4; ++m) _Pragma("unroll") for (int n = 0; n < 2; ++n) _Pragma("unroll") for (int k = 0; k < 2; ++k) \
        acc[ai][bj][m][n] = __builtin_amdgcn_mfma_f32_16x16x32_bf16(Bt[n][k], At[m][k], acc[ai][bj][m][n], 0, 0, 0); __builtin_amdgcn_s_setprio(0); } while (0)
#define PG8_WAIT_V(n) asm volatile("s_waitcnt vmcnt(" #n ")" ::: "memory")
#define PG8_WAIT_L(n) asm volatile("s_waitcnt lgkmcnt(" #n ")" ::: "memory")
#define PG8_BAR __builtin_amdgcn_s_barrier()
#define PG8_SCHED __builtin_amdgcn_sched_barrier(0)
    Unit cur, nxt; int ui = 0;
    if (!S.next(0, cur)) return;
    f32x4 acc[2][2][4][2];
#pragma unroll
    for (int a = 0; a < 2; ++a)
#pragma unroll
        for (int b = 0; b < 2; ++b)
#pragma unroll
            for (int m = 0; m < 4; ++m)
#pragma unroll
                for (int n = 0; n < 2; ++n) acc[a][b][m][n] = (f32x4){0.f, 0.f, 0.f, 0.f};
    bf16x8 At[4][2], B0[2][2], B1[2][2];
    const char* cA = (const char*)g.A + (size_t)cur.pm * tstep; const char* cB = (const char*)g.Bt + (size_t)cur.pn * tstep;
    S.a_ready(cur);
    if constexpr (SP2) {
        PG8_STAGE(PG8_SB(0, 0), cB, voffB); PG8_STAGE(PG8_SB(0, 1), cB + hstep, voffB); PG8_STAGE(PG8_SA(0, 0), cA, voffA); PG8_STAGE(PG8_SA(0, 1), cA + hstep, voffA);
        if (wr == 1) PG8_BAR;
        PG8_WAIT_V(2); PG8_BAR;
        PG8_STAGE(PG8_SB(1, 0), cB + kstep, voffB); PG8_STAGE(PG8_SA(1, 0), cA + kstep, voffA); PG8_STAGE(PG8_SB(1, 1), cB + hstep + kstep, voffB);
        PG8_WAIT_V(6); PG8_BAR;
    } else {
        PG8_STAGE(PG8_SB(0, 0), cB, voffB); PG8_STAGE(PG8_SA(0, 0), cA, voffA); PG8_STAGE(PG8_SB(0, 1), cB + hstep, voffB); PG8_STAGE(PG8_SA(0, 1), cA + hstep, voffA);
        if (wr == 1) PG8_BAR;
        PG8_WAIT_V(4); PG8_BAR;
        PG8_STAGE(PG8_SB(1, 0), cB + kstep, voffB); PG8_STAGE(PG8_SA(1, 0), cA + kstep, voffA); PG8_STAGE(PG8_SB(1, 1), cB + hstep + kstep, voffB);
        PG8_WAIT_V(6); PG8_BAR;
    }
    for (;;) {
        const bool has_next = S.next(ui + 1, nxt);
        const char* nA = has_next ? (const char*)g.A + (size_t)nxt.pm * tstep : cA; const char* nB = has_next ? (const char*)g.Bt + (size_t)nxt.pn * tstep : cB;
        for (int t = 0; t < nt; t += 2) {
            const bool last = (t == nt - 2);
            const char* a1 = cA + (size_t)(t + 1) * kstep;
            const char* a2 = last ? nA : cA + (size_t)(t + 2) * kstep; const char* b2 = last ? nB : cB + (size_t)(t + 2) * kstep;
            const char* a3 = a2 + kstep; const char* b3 = b2 + kstep;
            if (last && has_next) S.a_ready(nxt);
            if constexpr (SP2) {
            PG8_LDB(B0, 0, 0); PG8_LDB(B1, 0, 1); PG8_SCHED; PG8_LDA(At, 0, 0); PG8_STAGE(PG8_SA(1, 1), a1 + hstep, voffA);
            PG8_WAIT_V(8); PG8_WAIT_L(0); PG8_BAR; PG8_MMA(0, 0, At, B0); PG8_MMA(0, 1, At, B1); PG8_BAR; PG8_SCHED;
            PG8_LDA(At, 0, 1); PG8_STAGE(PG8_SB(0, 0), b2, voffB); PG8_STAGE(PG8_SB(0, 1), b2 + hstep, voffB); PG8_STAGE(PG8_SA(0, 0), a2, voffA);
            PG8_WAIT_V(8); PG8_WAIT_L(0); PG8_BAR; PG8_MMA(1, 0, At, B0); PG8_MMA(1, 1, At, B1); PG8_BAR; PG8_SCHED;
            PG8_LDB(B0, 1, 0); PG8_LDB(B1, 1, 1); PG8_SCHED; PG8_LDA(At, 1, 0); PG8_STAGE(PG8_SA(0, 1), a2 + hstep, voffA);
            PG8_WAIT_V(8); PG8_WAIT_L(0); PG8_BAR; PG8_MMA(0, 0, At, B0); PG8_MMA(0, 1, At, B1); PG8_BAR; PG8_SCHED;
            PG8_LDA(At, 1, 1); PG8_STAGE(PG8_SB(1, 0), b3, voffB); PG8_STAGE(PG8_SB(1, 1), b3 + hstep, voffB); PG8_STAGE(PG8_SA(1, 0), a3, voffA);
            PG8_WAIT_V(8); PG8_WAIT_L(0); PG8_BAR; PG8_MMA(1, 0, At, B0); PG8_MMA(1, 1, At, B1); PG8_BAR; PG8_SCHED;
            } else {
            PG8_LDB(B0, 0, 0); PG8_SCHED; PG8_LDA(At, 0, 0); PG8_STAGE(PG8_SA(1, 1), a1 + hstep, voffA);
            PG8_WAIT_L(8); PG8_BAR; PG8_WAIT_L(0); PG8_MMA(0, 0, At, B0); PG8_BAR; PG8_SCHED;
            PG8_LDB(B1, 0, 1); PG8_STAGE(PG8_SB(0, 0), b2, voffB);
            PG8_BAR; PG8_WAIT_L(0); PG8_MMA(0, 1, At, B1); PG8_BAR;
            PG8_LDA(At, 0, 1); PG8_STAGE(PG8_SA(0, 0), a2, voffA);
            PG8_BAR; PG8_WAIT_L(0); PG8_MMA(1, 0, At, B0); PG8_BAR; PG8_SCHED;
            PG8_STAGE(PG8_SB(0, 1), b2 + hstep, voffB);
            PG8_WAIT_V(6); PG8_BAR; PG8_MMA(1, 1, At, B1); PG8_BAR;
            PG8_LDB(B0, 1, 0); PG8_SCHED; PG8_LDA(At, 1, 0); PG8_STAGE(PG8_SA(0, 1), a2 + hstep, voffA);
            PG8_WAIT_L(8); PG8_BAR; PG8_WAIT_L(0); PG8_MMA(0, 0, At, B0); PG8_BAR; PG8_SCHED;
            PG8_LDB(B1, 1, 1); PG8_STAGE(PG8_SB(1, 0), b3, voffB);
            PG8_BAR; PG8_WAIT_L(0); PG8_MMA(0, 1, At, B1); PG8_BAR;
            PG8_LDA(At, 1, 1); PG8_STAGE(PG8_SA(1, 0), a3, voffA);
            PG8_BAR; PG8_WAIT_L(0); PG8_MMA(1, 0, At, B0); PG8_BAR; PG8_SCHED;
            PG8_STAGE(PG8_SB(1, 1), b3 + hstep, voffB);
            PG8_WAIT_V(6); PG8_BAR; PG8_MMA(1, 1, At, B1); PG8_BAR;
            }
        }
        if constexpr (ALIGN_EPI) { if (wr == 0) PG8_BAR; }
        if constexpr (!Epi::AFTER_DRAIN) { E(acc, cur, wr, wc, fr, fq); S.done(cur); }
        if (!has_next) break;
#pragma unroll
        for (int a = 0; a < 2; ++a)
#pragma unroll
            for (int b = 0; b < 2; ++b)
#pragma unroll
                for (int m = 0; m < 4; ++m)
#pragma unroll
                    for (int n = 0; n < 2; ++n) acc[a][b][m][n] = (f32x4){0.f, 0.f, 0.f, 0.f};
        cur = nxt; cA = nA; cB = nB; ++ui;
        if constexpr (ALIGN_EPI) { if (wr == 1) PG8_BAR; }
    }
    PG8_WAIT_V(0);
    if constexpr (!ALIGN_EPI) { if (wr == 0) PG8_BAR; }
    PG8_BAR;
    if constexpr (Epi::AFTER_DRAIN) { E.fused(acc, cur, wr, wc, fr, fq, lds, wid, lane); S.done(cur); }
#undef PG8_SA
#undef PG8_SB
#undef PG8_STAGE
#undef PG8_LDA
#undef PG8_LDB
#undef PG8_MMA
#undef PG8_WAIT_V
#undef PG8_WAIT_L
#undef PG8_BAR
#undef PG8_SCHED
}
}
#define XB_TMO      128
#define XB_XCNT(j)  (256  + 64 * (j))
#define XB_XSUB(j)  (1280 + 64 * (j))
#define XB_XGEN(j)  (2304 + 64 * (j))
#define XB_TOP      3328
#define XB_TOPGEN   3392
#define XCD_BAR_WORDS 3456
#define XB_SPIN_CAP (1u << 18)
#define LAS __attribute__((address_space(3)))

__device__ __forceinline__ unsigned xb_ld(unsigned* p)              { return __hip_atomic_load(p, __ATOMIC_RELAXED, __HIP_MEMORY_SCOPE_AGENT); }
__device__ __forceinline__ unsigned xb_add(unsigned* p, unsigned v) { return __hip_atomic_fetch_add(p, v, __ATOMIC_RELAXED, __HIP_MEMORY_SCOPE_AGENT); }
__device__ __forceinline__ unsigned xb_xcc_id() { return (unsigned)__builtin_amdgcn_s_getreg((3 << 11) | 20) & 0xFu; }
#define XB_SPIN(cond, bar) do { unsigned _sp = 0; while (cond) { __builtin_amdgcn_s_sleep(1); \
    if ((++_sp & 255u) == 0u) { if (xb_ld(&(bar)[XB_TMO])) break; if (_sp > XB_SPIN_CAP) { atomicAdd(&(bar)[XB_TMO], 1u); break; } } } } while (0)

struct XcdBarrier {
    unsigned* bar; unsigned x;
    volatile LAS unsigned* st;
};

__device__ __forceinline__ XcdBarrier xcd_barrier_post(unsigned* bar, volatile LAS unsigned* st) {
    XcdBarrier b; b.bar = bar; b.x = xb_xcc_id(); b.st = st;
    if (threadIdx.x == 0) (void)xb_add(&bar[XB_XCNT(b.x)], 1u);
    return b;
}
__device__ __forceinline__ void xcd_barrier_complete(unsigned* bar, unsigned x, unsigned& nloc, unsigned& nx) {
    const unsigned G = gridDim.x * gridDim.y * gridDim.z;
    unsigned sum, cnt, mine, sp = 0u;
    for (;;) {
        sum = 0u; cnt = 0u; mine = 0u;
#pragma unroll
        for (unsigned j = 0; j < 16; ++j) { const unsigned c = xb_ld(&bar[XB_XCNT(j)]); sum += c; cnt += (c > 0u) ? 1u : 0u; mine = (j == x) ? c : mine; }
        if (sum == G) break;
        __builtin_amdgcn_s_sleep(1);
        if ((++sp & 255u) == 0u) { if (xb_ld(&bar[XB_TMO])) break; if (sp > XB_SPIN_CAP) { atomicAdd(&bar[XB_TMO], 1u); break; } }
    }
    nloc = mine > 0u ? mine : 1u; nx = cnt > 0u ? cnt : 1u;
}

__device__ __forceinline__ void xcd_barrier(const XcdBarrier& b) {
    asm volatile("s_waitcnt vmcnt(0)" ::: "memory");
    __syncthreads();
    if (threadIdx.x == 0) {
        unsigned* bar = b.bar;
        __builtin_amdgcn_s_waitcnt(0);
        unsigned nloc = b.st[0], nx = b.st[1];
        if (nloc == 0u) { xcd_barrier_complete(bar, b.x, nloc, nx); b.st[0] = nloc; b.st[1] = nx; }
        const unsigned old = xb_add(&bar[XB_XSUB(b.x)], 1u);
        const unsigned gen = old / nloc;
        if (old + 1u == (gen + 1u) * nloc) {
            __builtin_amdgcn_fence(__ATOMIC_RELEASE, "agent");
            asm volatile("s_waitcnt vmcnt(0)" ::: "memory");
            const unsigned og = xb_add(&bar[XB_TOP], 1u);
            const unsigned tg = og / nx;
            if (og + 1u == (tg + 1u) * nx) xb_add(&bar[XB_TOPGEN], 1u);
            else XB_SPIN(xb_ld(&bar[XB_TOPGEN]) == tg, bar);
            __builtin_amdgcn_fence(__ATOMIC_ACQUIRE, "agent");
            xb_add(&bar[XB_XGEN(b.x)], 1u);
            asm volatile("s_waitcnt vmcnt(0)" ::: "memory");
        } else {
            XB_SPIN(xb_ld(&bar[XB_XGEN(b.x)]) == gen, bar);
            __builtin_amdgcn_fence(__ATOMIC_ACQUIRE, "agent");
            asm volatile("s_waitcnt vmcnt(0)" ::: "memory");
        }
    }
    __syncthreads();
}

DEVINL uint4 pack8(f32x4 a, f32x4 b) { return make_uint4(pack2(a[0], a[1]), pack2(a[2], a[3]), pack2(b[0], b[1]), pack2(b[2], b[3])); }
typedef const f32x4 (&AccRef)[2][2][4][2];

struct EpiInproj {
    static constexpr bool PERM = true, AFTER_DRAIN = false;
    bf16_t *sbq, *sbk, *sbvT, *dq, *dk, *dvT, *iq, *ik, *gates; float* iw; const float *cosT, *sinT, *bgate;
    DEVINL void operator()(AccRef acc, const pg8::Unit& u, int wr, int wc, int fr, int fq) const {
        const int cb = u.pn * 256 + wc * 64;
        if (cb >= N1) return;
        float4 bb[2][2];
        if (cb >= GATE0) {
#pragma unroll
            for (int bj = 0; bj < 2; bj++) { bb[bj][0] = *(const float4*)(bgate + cb - GATE0 + 32 * bj + 8 * fq); bb[bj][1] = *(const float4*)(bgate + cb - GATE0 + 32 * bj + 8 * fq + 4); }
        }
        if (cb >= 1536 && cb < 2880 && !(cb >= 2176 && cb < 2304)) {
            bf16_t* dst0; float sc = 1.f; int ld;
            if (cb < 2048) { dst0 = dq + (cb - 1536); sc = 0.18033688011112042f; ld = 512; }
            else if (cb < 2176) { dst0 = dk + (cb - 2048); ld = 128; }
            else if (cb < 2816) { dst0 = iq + (cb - 2304); sc = 0.125f; ld = 512; }
            else { dst0 = ik; ld = 64; }
            const int rowb = u.pm * 256 + wr * 64 + fr;
#pragma unroll
            for (int ai = 0; ai < 2; ai++)
#pragma unroll
                for (int mh = 0; mh < 2; mh++) {
                    float4 cs[2][2][2];
#pragma unroll
                    for (int mm = 0; mm < 2; mm++)
#pragma unroll
                        for (int n = 0; n < 2; n++) {
                            const int pos = (rowb + ai * 128 + (mh * 2 + mm) * 16) & 2047;
                            cs[mm][n][0] = *(const float4*)(cosT + pos * 32 + 8 * fq + 4 * n);
                            cs[mm][n][1] = *(const float4*)(sinT + pos * 32 + 8 * fq + 4 * n);
                        }
#pragma unroll
                    for (int mm = 0; mm < 2; mm++) {
                        const int m = mh * 2 + mm;
                        bf16_t* dst = dst0 + (size_t)(rowb + ai * 128 + m * 16) * ld;
                        f32x4 o1[2], o2[2];
#pragma unroll
                        for (int n = 0; n < 2; n++) {
                            const float4 c4 = cs[mm][n][0], s4 = cs[mm][n][1];
                            const f32x4 x1 = acc[ai][0][m][n], x2 = acc[ai][1][m][n];
                            o1[n][0] = (x1[0] * c4.x - x2[0] * s4.x) * sc; o2[n][0] = (x2[0] * c4.x + x1[0] * s4.x) * sc;
                            o1[n][1] = (x1[1] * c4.y - x2[1] * s4.y) * sc; o2[n][1] = (x2[1] * c4.y + x1[1] * s4.y) * sc;
                            o1[n][2] = (x1[2] * c4.z - x2[2] * s4.z) * sc; o2[n][2] = (x2[2] * c4.z + x1[2] * s4.z) * sc;
                            o1[n][3] = (x1[3] * c4.w - x2[3] * s4.w) * sc; o2[n][3] = (x2[3] * c4.w + x1[3] * s4.w) * sc;
                        }
                        *(uint4*)(dst + 8 * fq) = pack8(o1[0], o1[1]);
                        *(uint4*)(dst + 32 + 8 * fq) = pack8(o2[0], o2[1]);
                    }
                }
            return;
        }
#pragma unroll
        for (int ai = 0; ai < 2; ai++)
#pragma unroll
            for (int m = 0; m < 4; m++) {
                const int row = u.pm * 256 + ai * 128 + wr * 64 + m * 16 + fr;
                const int pos = row & 2047, b = row >> 11;
                if (cb >= GATE0) {
#pragma unroll
                    for (int bj = 0; bj < 2; bj++) {
                        const int col = cb - GATE0 + 32 * bj + 8 * fq;
                        const float4 b0 = bb[bj][0], b1 = bb[bj][1];
                        f32x4 v0 = acc[ai][bj][m][0], v1 = acc[ai][bj][m][1];
                        v0[0] = __builtin_amdgcn_rcpf(1.f + __expf(-(v0[0] + b0.x))); v0[1] = __builtin_amdgcn_rcpf(1.f + __expf(-(v0[1] + b0.y)));
                        v0[2] = __builtin_amdgcn_rcpf(1.f + __expf(-(v0[2] + b0.z))); v0[3] = __builtin_amdgcn_rcpf(1.f + __expf(-(v0[3] + b0.w)));
                        v1[0] = __builtin_amdgcn_rcpf(1.f + __expf(-(v1[0] + b1.x))); v1[1] = __builtin_amdgcn_rcpf(1.f + __expf(-(v1[1] + b1.y)));
                        v1[2] = __builtin_amdgcn_rcpf(1.f + __expf(-(v1[2] + b1.z))); v1[3] = __builtin_amdgcn_rcpf(1.f + __expf(-(v1[3] + b1.w)));
                        *(uint4*)(gates + (size_t)row * 2048 + col) = pack8(v0, v1);
                    }
                } else if (cb < 1024) {
                    const float sc = cb < 512 ? 0.18033688011112042f : 1.f;
                    bf16_t* dst = (cb < 512 ? sbq + (size_t)row * 512 + cb : sbk + (size_t)row * 512 + (cb - 512));
#pragma unroll
                    for (int bj = 0; bj < 2; bj++) *(uint4*)(dst + 32 * bj + 8 * fq) = pack8(acc[ai][bj][m][0] * sc, acc[ai][bj][m][1] * sc);
                } else if (cb < 1536 || (cb >= 2176 && cb < 2304)) {
                    bf16_t* dst = (cb < 1536) ? sbvT + ((size_t)((b * 8 + ((cb - 1024) >> 6)) * 64)) * 2048 + pos
                                              : dvT + ((size_t)((b * 2 + ((cb - 2176) >> 6)) * 64)) * 2048 + pos;
#pragma unroll
                    for (int bj = 0; bj < 2; bj++)
#pragma unroll
                        for (int n = 0; n < 2; n++)
#pragma unroll
                            for (int r = 0; r < 4; r++) dst[(size_t)(32 * bj + 8 * fq + 4 * n + r) * 2048] = f2bf(acc[ai][bj][m][n][r]);
                } else if (cb < 2880) {
                    bf16_t* dst; float sc = 1.f;
                    if (cb < 2048) { dst = dq + (size_t)row * 512 + (cb - 1536); sc = 0.18033688011112042f; }
                    else if (cb < 2176) { dst = dk + (size_t)row * 128 + (cb - 2048); }
                    else if (cb < 2816) { dst = iq + (size_t)row * 512 + (cb - 2304); sc = 0.125f; }
                    else { dst = ik + (size_t)row * 64; }
                    f32x4 o1[2], o2[2];
#pragma unroll
                    for (int n = 0; n < 2; n++) {
                        const int i0 = 8 * fq + 4 * n;
                        const float4 c4 = *(const float4*)(cosT + pos * 32 + i0);
                        const float4 s4 = *(const float4*)(sinT + pos * 32 + i0);
                        const f32x4 x1 = acc[ai][0][m][n], x2 = acc[ai][1][m][n];
                        o1[n][0] = (x1[0] * c4.x - x2[0] * s4.x) * sc; o2[n][0] = (x2[0] * c4.x + x1[0] * s4.x) * sc;
                        o1[n][1] = (x1[1] * c4.y - x2[1] * s4.y) * sc; o2[n][1] = (x2[1] * c4.y + x1[1] * s4.y) * sc;
                        o1[n][2] = (x1[2] * c4.z - x2[2] * s4.z) * sc; o2[n][2] = (x2[2] * c4.z + x1[2] * s4.z) * sc;
                        o1[n][3] = (x1[3] * c4.w - x2[3] * s4.w) * sc; o2[n][3] = (x2[3] * c4.w + x1[3] * s4.w) * sc;
                    }
                    *(uint4*)(dst + 8 * fq) = pack8(o1[0], o1[1]);
                    *(uint4*)(dst + 32 + 8 * fq) = pack8(o2[0], o2[1]);
                } else {
                    if (fq == 0) {
                        const f32x4 v0 = acc[ai][0][m][0] * 0.35355339059327373f, v1 = acc[ai][0][m][1] * 0.35355339059327373f;
                        *(float4*)(iw + (size_t)row * 8) = make_float4(v0[0], v0[1], v0[2], v0[3]);
                        *(float4*)(iw + (size_t)row * 8 + 4) = make_float4(v1[0], v1[1], v1[2], v1[3]);
                    }
                }
            }
    }
};

struct EpiMemKV {
    static constexpr bool PERM = true, AFTER_DRAIN = false;
    bf16_t *kmem, *vmemT;
    DEVINL void operator()(AccRef acc, const pg8::Unit& u, int wr, int wc, int fr, int fq) const {
#pragma unroll
        for (int ai = 0; ai < 2; ai++)
#pragma unroll
            for (int m = 0; m < 4; m++) {
                const int row = u.pm * 256 + ai * 128 + wr * 64 + m * 16 + fr;
#pragma unroll
                for (int bj = 0; bj < 2; bj++) {
                    const int col = u.pn * 256 + bj * 128 + wc * 32 + 8 * fq;
                    if (col < 512) {
                        *(uint4*)(kmem + (size_t)row * 512 + col) = pack8(acc[ai][bj][m][0], acc[ai][bj][m][1]);
                    } else {
                        const int b = row >> 8, key = row & 255, h = (col - 512) >> 7, d0 = (col - 512) & 127;
                        bf16_t* dst = vmemT + ((size_t)((b * 4 + h) * 128 + d0)) * 256 + key;
#pragma unroll
                        for (int n = 0; n < 2; n++)
#pragma unroll
                            for (int r = 0; r < 4; r++) dst[(size_t)(4 * n + r) * 256] = f2bf(acc[ai][bj][m][n][r]);
                    }
                }
            }
    }
};

struct EpiMerge {
    static constexpr bool PERM = true, AFTER_DRAIN = false;
    const bf16_t* gates; bf16_t* merged; int accum;
    DEVINL void operator()(AccRef acc, const pg8::Unit& u, int wr, int wc, int fr, int fq) const {
#pragma unroll
        for (int ai = 0; ai < 2; ai++)
#pragma unroll
            for (int m = 0; m < 4; m++) {
                const int row = u.pm * 256 + ai * 128 + wr * 64 + m * 16 + fr;
#pragma unroll
                for (int bj = 0; bj < 2; bj++) {
                    const int col = u.pn * 256 + bj * 128 + wc * 32 + 8 * fq;
                    const uint4 g = *(const uint4*)(gates + (size_t)row * 2048 + col);
                    f32x4 v0 = acc[ai][bj][m][0], v1 = acc[ai][bj][m][1];
                    v0[0] *= bf2f(g.x & 0xffffu); v0[1] *= bf2f(g.x >> 16); v0[2] *= bf2f(g.y & 0xffffu); v0[3] *= bf2f(g.y >> 16);
                    v1[0] *= bf2f(g.z & 0xffffu); v1[1] *= bf2f(g.z >> 16); v1[2] *= bf2f(g.w & 0xffffu); v1[3] *= bf2f(g.w >> 16);
                    bf16_t* dst = merged + (size_t)row * 1024 + col;
                    if (accum) {
                        const uint4 o = *(const uint4*)dst;
                        v0[0] += bf2f(o.x & 0xffffu); v0[1] += bf2f(o.x >> 16); v0[2] += bf2f(o.y & 0xffffu); v0[3] += bf2f(o.y >> 16);
                        v1[0] += bf2f(o.z & 0xffffu); v1[1] += bf2f(o.z >> 16); v1[2] += bf2f(o.w & 0xffffu); v1[3] += bf2f(o.w >> 16);
                    }
                    *(uint4*)dst = pack8(v0, v1);
                }
            }
    }
};

template <bool F32RES>
struct EpiResid {
    static constexpr bool PERM = true, AFTER_DRAIN = false;
    const float* res32; bf16_t* hb; float* rowss;
    DEVINL void operator()(AccRef acc, const pg8::Unit& u, int wr, int wc, int fr, int fq) const {
        const int rowb = u.pm * 256 + wr * 64 + fr, colb = u.pn * 256 + wc * 32 + 8 * fq;
#pragma unroll
        for (int ai = 0; ai < 2; ai++)
#pragma unroll
        for (int mh = 0; mh < 2; mh++) {
            float4 xx[2][2][2]; uint4 oo[2][2];
#pragma unroll
            for (int mm = 0; mm < 2; mm++)
#pragma unroll
                for (int bj = 0; bj < 2; bj++) {
                    const int row = rowb + ai * 128 + (mh * 2 + mm) * 16, col = colb + bj * 128;
                    if (F32RES) { xx[mm][bj][0] = *(const float4*)(res32 + (size_t)row * 1024 + col); xx[mm][bj][1] = *(const float4*)(res32 + (size_t)row * 1024 + col + 4); }
                    else oo[mm][bj] = *(const uint4*)(hb + (size_t)row * 1024 + col);
                }
#pragma unroll
            for (int mm = 0; mm < 2; mm++) {
                const int m = mh * 2 + mm;
                const int row = rowb + ai * 128 + m * 16;
                float ss = 0.f;
#pragma unroll
                for (int bj = 0; bj < 2; bj++) {
                    const int col = colb + bj * 128;
                    f32x4 v0 = acc[ai][bj][m][0], v1 = acc[ai][bj][m][1];
                    if (F32RES) {
                        const float4 x0 = xx[mm][bj][0], x1 = xx[mm][bj][1];
                        v0[0] += x0.x; v0[1] += x0.y; v0[2] += x0.z; v0[3] += x0.w; v1[0] += x1.x; v1[1] += x1.y; v1[2] += x1.z; v1[3] += x1.w;
                    } else {
                        const uint4 o = oo[mm][bj];
                        v0[0] += bf2f(o.x & 0xffffu); v0[1] += bf2f(o.x >> 16); v0[2] += bf2f(o.y & 0xffffu); v0[3] += bf2f(o.y >> 16);
                        v1[0] += bf2f(o.z & 0xffffu); v1[1] += bf2f(o.z >> 16); v1[2] += bf2f(o.w & 0xffffu); v1[3] += bf2f(o.w >> 16);
                    }
                    *(uint4*)(hb + (size_t)row * 1024 + col) = pack8(v0, v1);
                    ss += v0[0] * v0[0] + v0[1] * v0[1] + v0[2] * v0[2] + v0[3] * v0[3] + v1[0] * v1[0] + v1[1] * v1[1] + v1[2] * v1[2] + v1[3] * v1[3];
                }
                ss += __shfl_xor(ss, 16); ss += __shfl_xor(ss, 32);
                if (fq == 0) atomicAdd(rowss + row, ss);
            }
        }
    }
};

struct EpiFinal {
    static constexpr bool PERM = true, AFTER_DRAIN = true;
    const bf16_t* hb; float* out; const float* gfin; float* X; unsigned* cnt;
    DEVINL void operator()(AccRef, const pg8::Unit&, int, int, int, int) const {}
    DEVINL void fused(f32x4 (&acc)[2][2][4][2], const pg8::Unit& u, int wr, int wc, int fr, int fq, __attribute__((address_space(3))) unsigned char* ldsb, int, int) const {
        float* part = (float*)(ldsb + 131072);
        float* rsb = part + 1024;
        const int tid = threadIdx.x;
#pragma unroll
        for (int ai = 0; ai < 2; ai++) {
            uint4 oo[4][2];
#pragma unroll
            for (int m = 0; m < 4; m++)
#pragma unroll
                for (int bj = 0; bj < 2; bj++)
                    oo[m][bj] = *(const uint4*)(hb + (size_t)(u.pm * 256 + ai * 128 + wr * 64 + m * 16 + fr) * 1024 + u.pn * 256 + bj * 128 + wc * 32 + 8 * fq);
#pragma unroll
            for (int m = 0; m < 4; m++) {
                const int rowl = ai * 128 + wr * 64 + m * 16 + fr;
                float ss = 0.f;
#pragma unroll
                for (int bj = 0; bj < 2; bj++) {
                    const uint4 o = oo[m][bj];
                    f32x4& v0 = acc[ai][bj][m][0]; f32x4& v1 = acc[ai][bj][m][1];
                    v0[0] += bf2f(o.x & 0xffffu); v0[1] += bf2f(o.x >> 16); v0[2] += bf2f(o.y & 0xffffu); v0[3] += bf2f(o.y >> 16);
                    v1[0] += bf2f(o.z & 0xffffu); v1[1] += bf2f(o.z >> 16); v1[2] += bf2f(o.w & 0xffffu); v1[3] += bf2f(o.w >> 16);
                    ss += v0[0] * v0[0] + v0[1] * v0[1] + v0[2] * v0[2] + v0[3] * v0[3] + v1[0] * v1[0] + v1[1] * v1[1] + v1[2] * v1[2] + v1[3] * v1[3];
                }
                ss += __shfl_xor(ss, 16); ss += __shfl_xor(ss, 32);
                if (fq == 0) part[wc * 256 + rowl] = ss;
            }
        }
        __syncthreads();
        if (tid < 256) __hip_atomic_store(X + (size_t)(u.pm * 4 + u.pn) * 256 + tid, (part[tid] + part[256 + tid]) + (part[512 + tid] + part[768 + tid]), __ATOMIC_RELAXED, __HIP_MEMORY_SCOPE_AGENT);
        asm volatile("s_waitcnt vmcnt(0)" ::: "memory");
        __syncthreads();
        if (tid == 0) {
            __hip_atomic_fetch_add(cnt + u.pm, 1u, __ATOMIC_RELAXED, __HIP_MEMORY_SCOPE_AGENT);
            unsigned spins = 0;
            while (__hip_atomic_load(cnt + u.pm, __ATOMIC_RELAXED, __HIP_MEMORY_SCOPE_AGENT) < 4u) { __builtin_amdgcn_s_sleep(1); if (++spins > (1u << 22)) break; }
        }
        __syncthreads();
        if (tid < 256) {
            float* xp = X + (size_t)(u.pm * 4) * 256 + tid;
            const float s = (__hip_atomic_load(xp, __ATOMIC_RELAXED, __HIP_MEMORY_SCOPE_AGENT) + __hip_atomic_load(xp + 256, __ATOMIC_RELAXED, __HIP_MEMORY_SCOPE_AGENT)) +
                            (__hip_atomic_load(xp + 512, __ATOMIC_RELAXED, __HIP_MEMORY_SCOPE_AGENT) + __hip_atomic_load(xp + 768, __ATOMIC_RELAXED, __HIP_MEMORY_SCOPE_AGENT));
            rsb[tid] = rsqrtf(s * (1.f / 1024.f) + EPS);
        }
        float4 gg[2][2];
#pragma unroll
        for (int bj = 0; bj < 2; bj++) { gg[bj][0] = *(const float4*)(gfin + u.pn * 256 + bj * 128 + wc * 32 + 8 * fq); gg[bj][1] = *(const float4*)(gfin + u.pn * 256 + bj * 128 + wc * 32 + 8 * fq + 4); }
        __syncthreads();
#pragma unroll
        for (int ai = 0; ai < 2; ai++)
#pragma unroll
            for (int m = 0; m < 4; m++) {
                const int rowl = ai * 128 + wr * 64 + m * 16 + fr;
                const int row = u.pm * 256 + rowl;
                const float rs = rsb[rowl];
#pragma unroll
                for (int bj = 0; bj < 2; bj++) {
                    const int col = u.pn * 256 + bj * 128 + wc * 32 + 8 * fq;
                    const float4 g0 = gg[bj][0], g1 = gg[bj][1];
                    const f32x4 v0 = acc[ai][bj][m][0] * rs, v1 = acc[ai][bj][m][1] * rs;
                    *(float4*)(out + (size_t)row * 1024 + col) = make_float4(v0[0] * g0.x, v0[1] * g0.y, v0[2] * g0.z, v0[3] * g0.w);
                    *(float4*)(out + (size_t)row * 1024 + col + 4) = make_float4(v1[0] * g1.x, v1[1] * g1.y, v1[2] * g1.z, v1[3] * g1.w);
                }
            }
    }
};

struct EpiCq {
    static constexpr bool PERM = true, AFTER_DRAIN = false;
    const float* rowss1; bf16_t* qc;
    DEVINL void operator()(AccRef acc, const pg8::Unit& u, int wr, int wc, int fr, int fq) const {
        float rsv[2][4];
#pragma unroll
        for (int ai = 0; ai < 2; ai++)
#pragma unroll
            for (int m = 0; m < 4; m++) rsv[ai][m] = rowss1[u.pm * 256 + ai * 128 + wr * 64 + m * 16 + fr];
#pragma unroll
        for (int ai = 0; ai < 2; ai++)
#pragma unroll
            for (int m = 0; m < 4; m++) {
                const int row = u.pm * 256 + ai * 128 + wr * 64 + m * 16 + fr;
                const float rs = rsqrtf(rsv[ai][m] * (1.f / 1024.f) + EPS) * 0.12751743074602467f;
#pragma unroll
                for (int bj = 0; bj < 2; bj++)
                    *(uint4*)(qc + (size_t)row * 512 + u.pn * 256 + bj * 128 + wc * 32 + 8 * fq) = pack8(acc[ai][bj][m][0] * rs, acc[ai][bj][m][1] * rs);
            }
    }
};

struct EpiUp {
    static constexpr bool PERM = true, AFTER_DRAIN = false;
    const float* rowss2; bf16_t* hdn;
    DEVINL void operator()(AccRef acc, const pg8::Unit& u, int wr, int wc, int fr, int fq) const {
        float rsv[2][4];
#pragma unroll
        for (int ai = 0; ai < 2; ai++)
#pragma unroll
            for (int m = 0; m < 4; m++) rsv[ai][m] = rowss2[u.pm * 256 + ai * 128 + wr * 64 + m * 16 + fr];
#pragma unroll
        for (int ai = 0; ai < 2; ai++)
#pragma unroll
            for (int m = 0; m < 4; m++) {
                const int row = u.pm * 256 + ai * 128 + wr * 64 + m * 16 + fr;
                const float rs = rsqrtf(rsv[ai][m] * (1.f / 1024.f) + EPS);
#pragma unroll
                for (int bj = 0; bj < 2; bj++) {
                    f32x4 v0 = acc[ai][bj][m][0] * rs, v1 = acc[ai][bj][m][1] * rs;
#pragma unroll
                    for (int r = 0; r < 4; r++) { v0[r] = fmaxf(v0[r], 0.f); v1[r] = fmaxf(v1[r], 0.f); }
                    *(uint4*)(hdn + (size_t)row * 4096 + u.pn * 256 + bj * 128 + wc * 32 + 8 * fq) = pack8(v0 * v0, v1 * v1);
                }
            }
    }
};

constexpr int LDP = 72;
struct MergeOrder {
    pg8::StaticOrder S;
    DEVINL bool next(int i, pg8::Unit& u) const { pg8::Unit t; if (!S.next(i >> 1, t)) return false; u.pm = t.pm + 64 * (i & 1); u.pn = t.pn + 4 * (i & 1); return true; }
    DEVINL void a_ready(const pg8::Unit&) const {}
    DEVINL void done(const pg8::Unit&) const {}
};
struct EpiMerge2 {
    static constexpr bool PERM = true, AFTER_DRAIN = false;
    const bf16_t* gates; bf16_t* merged;
    DEVINL void operator()(AccRef acc, const pg8::Unit& u, int wr, int wc, int fr, int fq) const {
        const int second = u.pm >= 64;
        const int pm = u.pm & 63, pn = u.pn & 3;
        const int rowb = pm * 256 + wr * 64 + fr, colb = pn * 256 + wc * 32 + 8 * fq;
#pragma unroll
        for (int ai = 0; ai < 2; ai++)
#pragma unroll
        for (int mh = 0; mh < 2; mh++) {
            uint4 gg[2][2], oo[2][2];
#pragma unroll
            for (int mm = 0; mm < 2; mm++)
#pragma unroll
                for (int bj = 0; bj < 2; bj++) {
                    const int row = rowb + ai * 128 + (mh * 2 + mm) * 16, col = colb + bj * 128;
                    gg[mm][bj] = *(const uint4*)(gates + (size_t)row * 2048 + second * 1024 + col);
                    if (second) oo[mm][bj] = *(const uint4*)(merged + (size_t)row * 1024 + col);
                }
#pragma unroll
            for (int mm = 0; mm < 2; mm++)
#pragma unroll
                for (int bj = 0; bj < 2; bj++) {
                    const int m = mh * 2 + mm;
                    const int row = rowb + ai * 128 + m * 16, col = colb + bj * 128;
                    const uint4 g = gg[mm][bj];
                    f32x4 v0 = acc[ai][bj][m][0], v1 = acc[ai][bj][m][1];
                    v0[0] *= bf2f(g.x & 0xffffu); v0[1] *= bf2f(g.x >> 16); v0[2] *= bf2f(g.y & 0xffffu); v0[3] *= bf2f(g.y >> 16);
                    v1[0] *= bf2f(g.z & 0xffffu); v1[1] *= bf2f(g.z >> 16); v1[2] *= bf2f(g.w & 0xffffu); v1[3] *= bf2f(g.w >> 16);
                    if (second) {
                        const uint4 o = oo[mm][bj];
                        v0[0] += bf2f(o.x & 0xffffu); v0[1] += bf2f(o.x >> 16); v0[2] += bf2f(o.y & 0xffffu); v0[3] += bf2f(o.y >> 16);
                        v1[0] += bf2f(o.z & 0xffffu); v1[1] += bf2f(o.z >> 16); v1[2] += bf2f(o.w & 0xffffu); v1[3] += bf2f(o.w >> 16);
                    }
                    *(uint4*)(merged + (size_t)row * 1024 + col) = pack8(v0, v1);
                }
        }
    }
};

typedef __attribute__((address_space(3))) unsigned char* lds_ptr_t;
template <class Epi, bool MULTI>
DEVINL void run_gemm(unsigned char* lds, const bf16_t* A, const bf16_t* Bt, int M, int N, int K, const Epi& E, int c_override = -1) {
    pg8::Gemm g{A, Bt, M, N, K};
    pg8::StaticOrder S; S.init(M, N, (int)gridDim.x, c_override >= 0 ? c_override : (int)blockIdx.x);
    pg8::gemm_phase<Epi, pg8::StaticOrder, MULTI, true>((lds_ptr_t)lds, g, S, E);
}

DEVINL void phase_inproj(const KParams& p, unsigned char* lds) {
    unsigned char* ws = p.ws;
    EpiInproj E{(bf16_t*)(ws + OFF_SBQ), (bf16_t*)(ws + OFF_SBK), (bf16_t*)(ws + OFF_SBVT), (bf16_t*)(ws + OFF_DQ), (bf16_t*)(ws + OFF_DK), (bf16_t*)(ws + OFF_DVT),
                (bf16_t*)(ws + OFF_IQ), (bf16_t*)(ws + OFF_IK), (bf16_t*)(ws + OFF_GATES), (float*)(ws + OFF_IW),
                (const float*)(ws + OFF_ROPEC), (const float*)(ws + OFF_ROPES), p.in[7]};
    run_gemm<EpiInproj, true>(lds, (const bf16_t*)(ws + OFF_U0), (const bf16_t*)(ws + OFF_WT1), 16384, N1P, 1024, E);
}

#ifndef REP_A
#define REP_A 1
#endif
#ifndef REP_B
#define REP_B 1
#endif
#ifndef REP_C
#define REP_C 1
#endif
#ifndef REP_SB
#define REP_SB 1
#endif
template <int CTRL> DEVINL float dpp_f(float v) { return __builtin_bit_cast(float, __builtin_amdgcn_update_dpp(0, __builtin_bit_cast(int, v), CTRL, 0xF, 0xF, true)); }
template <int CTRL> DEVINL int dpp_i(int v) { return __builtin_amdgcn_update_dpp(0, v, CTRL, 0xF, 0xF, true); }
DEVINL int wave_sum_i_fast(int v) {
    v += dpp_i<0xB1>(v); v += dpp_i<0x4E>(v); v += dpp_i<0x141>(v); v += dpp_i<0x140>(v);
    { auto r = __builtin_amdgcn_permlane16_swap((unsigned)v, (unsigned)v, false, false); v = (int)(r[0] + r[1]); }
    { auto r = __builtin_amdgcn_permlane32_swap((unsigned)v, (unsigned)v, false, false); v = (int)(r[0] + r[1]); }
    return v;
}
DEVINL float lq_max(float v) {
    { auto r = __builtin_amdgcn_permlane16_swap(__float_as_uint(v), __float_as_uint(v), false, false); v = fmaxf(__uint_as_float(r[0]), __uint_as_float(r[1])); }
    { auto r = __builtin_amdgcn_permlane32_swap(__float_as_uint(v), __float_as_uint(v), false, false); v = fmaxf(__uint_as_float(r[0]), __uint_as_float(r[1])); }
    return v;
}
DEVINL float lq_sum(float v) {
    { auto r = __builtin_amdgcn_permlane16_swap(__float_as_uint(v), __float_as_uint(v), false, false); v = __uint_as_float(r[0]) + __uint_as_float(r[1]); }
    { auto r = __builtin_amdgcn_permlane32_swap(__float_as_uint(v), __float_as_uint(v), false, false); v = __uint_as_float(r[0]) + __uint_as_float(r[1]); }
    return v;
}
#define QUAD_XOR1 0xB1
#define QUAD_XOR2 0x4E
DEVINL int opaque_tid() { int t = threadIdx.x; asm volatile("" : "+v"(t)); return t; }
#define WAVE_LDS_SYNC() do { __builtin_amdgcn_fence(__ATOMIC_RELEASE, "wavefront"); __builtin_amdgcn_wave_barrier(); __builtin_amdgcn_fence(__ATOMIC_ACQUIRE, "wavefront"); } while (0)
DEVINL void sb_unit(const KParams& p, unsigned char* lds, int b, int hp, int qt) {
    unsigned char* ws = p.ws;
    const bf16_t* sbq = (const bf16_t*)(ws + OFF_SBQ); const bf16_t* sbk = (const bf16_t*)(ws + OFF_SBK); const bf16_t* sbvT = (const bf16_t*)(ws + OFF_SBVT);
    bf16_t* osb = (bf16_t*)(ws + OFF_OSB);
    bf16_t* Ks = (bf16_t*)lds;
    bf16_t* Vt = Ks + 2 * 64 * LDP;
    float* Ls = (float*)(lds + 8 * 64 * LDP * 2);
    const int tid = opaque_tid(), lane = tid & 63, wave = __builtin_amdgcn_readfirstlane(tid >> 6), lr = lane & 15, lq = lane >> 4;
    const int hw = wave >> 2, h = 2 * hp + hw;
    const int t0 = qt * 64, tw0 = t0 + (wave & 3) * 16;
    const size_t tokbase = (size_t)b * 2048;
    bf16x8 qf[2];
    qf[0] = *(const bf16x8*)(sbq + (tokbase + tw0 + lr) * 512 + h * 64 + lq * 8);
    qf[1] = *(const bf16x8*)(sbq + (tokbase + tw0 + lr) * 512 + h * 64 + 32 + lq * 8);
    f32x4 oacc[4];
#pragma unroll
    for (int n = 0; n < 4; n++) oacc[n] = f32x4{0.f, 0.f, 0.f, 0.f};
    float carry = 0.f;
    const int srow = lane >> 2, sq = lane & 3;
    const int t_s = tw0 + srow;
    float* Lrow_w = Ls + (wave * 16 + lr) * 68;
    float* Lrow_s = Ls + (wave * 16 + srow) * 68;
    const int cr = tid >> 3, cc = (tid & 7) * 8;
    const bf16_t* kg = sbk + (tokbase + cr) * 512 + 2 * hp * 64 + cc;
    const bf16_t* vg = sbvT + ((size_t)((b * 8 + 2 * hp) * 64 + cr)) * 2048 + cc;
    int jt = qt;
    {
        const uint4 pk = *(const uint4*)(kg + (size_t)jt * 64 * 512), pk2 = *(const uint4*)(kg + (size_t)jt * 64 * 512 + 64);
        const uint4 pv = *(const uint4*)(vg + jt * 64), pv2 = *(const uint4*)(vg + (size_t)64 * 2048 + jt * 64);
        *(uint4*)(Ks + cr * LDP + cc) = pk; *(uint4*)(Ks + (64 + cr) * LDP + cc) = pk2;
        *(uint4*)(Vt + cr * LDP + cc) = pv; *(uint4*)(Vt + (64 + cr) * LDP + cc) = pv2;
    }
    __builtin_amdgcn_s_waitcnt(0x0F70);
    __syncthreads();
    int buf = 0;
    for (; jt >= 0; --jt, buf ^= 1) {
        const int j0 = jt * 64;
        uint4 pk, pv, pk2, pv2;
        if (jt > 0) {
            pk = *(const uint4*)(kg + (size_t)(jt - 1) * 64 * 512); pk2 = *(const uint4*)(kg + (size_t)(jt - 1) * 64 * 512 + 64);
            pv = *(const uint4*)(vg + (jt - 1) * 64); pv2 = *(const uint4*)(vg + (size_t)64 * 2048 + (jt - 1) * 64);
        }
        const bf16_t* Kc = Ks + buf * (4 * 64 * LDP) + hw * 64 * LDP;
        const bf16_t* Vc = Vt + buf * (4 * 64 * LDP) + hw * 64 * LDP;
        if (j0 < tw0 + 16 && __ballot(carry < 64.f) != 0ull) {
            f32x4 lg[4];
#pragma unroll
            for (int n = 0; n < 4; n++) lg[n] = f32x4{0.f, 0.f, 0.f, 0.f};
#pragma unroll
            for (int ks = 0; ks < 2; ks++)
#pragma unroll
                for (int n = 0; n < 4; n++) {
                    const bf16x8 kf = *(const bf16x8*)(Kc + (n * 16 + lr) * LDP + ks * 32 + lq * 8);
                    lg[n] = mfma16(kf, qf[ks], lg[n]);
                }
            const int t_r = tw0 + lr;
            float spv[4][4], tot[4], hi[4];
#pragma unroll
            for (int n = 0; n < 4; n++) {
                float g = 0.f;
#pragma unroll
                for (int r = 0; r < 4; r++) {
                    const float z = lg[n][r];
                    const float s2 = fmaxf(z, 0.f) + __builtin_amdgcn_logf(1.f + __builtin_amdgcn_exp2f(-fabsf(z)));
                    spv[n][r] = (j0 + n * 16 + lq * 4 + r < t_r) ? s2 : 0.f;
                    g += spv[n][r];
                }
                const auto r16 = __builtin_amdgcn_permlane16_swap(__float_as_uint(g), __float_as_uint(g), false, false);
                const float x16 = __uint_as_float((lq & 1) ? r16[0] : r16[1]);
                const auto r32 = __builtin_amdgcn_permlane32_swap(__float_as_uint(g), __float_as_uint(g), false, false);
                const float x32 = __uint_as_float((lq >= 2) ? r32[0] : r32[1]);
                const auto r48 = __builtin_amdgcn_permlane16_swap(__float_as_uint(x32), __float_as_uint(x32), false, false);
                const float x48 = __uint_as_float((lq & 1) ? r48[0] : r48[1]);
                tot[n] = (g + x16) + (x32 + x48);
                hi[n] = ((lq & 1) ? 0.f : x16) + ((lq < 2) ? (x32 + x48) : 0.f);
            }
            float base = carry;
#pragma unroll
            for (int n = 3; n >= 0; n--) {
                float run = base + hi[n];
#pragma unroll
                for (int r = 3; r >= 0; r--) {
                    run += spv[n][r];
                    lg[n][r] = (j0 + n * 16 + lq * 4 + r < t_r) ? __builtin_amdgcn_exp2f(lg[n][r] - run) : 0.f;
                }
                base += tot[n];
            }
            carry = base;
#pragma unroll
            for (int ks = 0; ks < 2; ks++) {
                const uint4 pu = make_uint4(pack2(lg[2 * ks][0], lg[2 * ks][1]), pack2(lg[2 * ks][2], lg[2 * ks][3]),
                                            pack2(lg[2 * ks + 1][0], lg[2 * ks + 1][1]), pack2(lg[2 * ks + 1][2], lg[2 * ks + 1][3]));
                const bf16x8 pf = __builtin_bit_cast(bf16x8, pu);
#pragma unroll
                for (int n = 0; n < 4; n++) {
                    const bf16_t* vrow = Vc + (n * 16 + lr) * LDP + ks * 32 + lq * 4;
                    const uint2 v0 = *(const uint2*)(vrow), v1 = *(const uint2*)(vrow + 16);
                    const bf16x8 vf = __builtin_bit_cast(bf16x8, make_uint4(v0.x, v0.y, v1.x, v1.y));
                    oacc[n] = mfma16(vf, pf, oacc[n]);
                }
            }
        }
        if (jt > 0) {
            bf16_t* Kn = Ks + (buf ^ 1) * (4 * 64 * LDP); bf16_t* Vn = Vt + (buf ^ 1) * (4 * 64 * LDP);
            *(uint4*)(Kn + cr * LDP + cc) = pk; *(uint4*)(Kn + (64 + cr) * LDP + cc) = pk2;
            *(uint4*)(Vn + cr * LDP + cc) = pv; *(uint4*)(Vn + (64 + cr) * LDP + cc) = pv2;
        }
        {
            int* dflag = (int*)(lds + 8 * 64 * LDP * 2) + buf * 8;
            if (lane == 0) dflag[wave] = (__ballot(carry < 64.f) == 0ull) ? 1 : 0;
            __syncthreads();
            const int4 f0 = *(const int4*)dflag, f1 = *(const int4*)(dflag + 4);
            if ((f0.x & f0.y & f0.z & f0.w & f1.x & f1.y & f1.z & f1.w) != 0) break;
        }
    }
#pragma unroll
    for (int n = 0; n < 4; n++)
        *(uint2*)(osb + (tokbase + tw0 + lr) * 512 + h * 64 + n * 16 + lq * 4) = pack4(oacc[n]);
}

DEVINL void dsa_unit(const KParams& p, unsigned char* lds, int b, int qt) {
    unsigned char* ws = p.ws;
    const bf16_t* dq = (const bf16_t*)(ws + OFF_DQ); const bf16_t* dk = (const bf16_t*)(ws + OFF_DK); const bf16_t* dvT = (const bf16_t*)(ws + OFF_DVT);
    const bf16_t* iq = (const bf16_t*)(ws + OFF_IQ); const bf16_t* ik = (const bf16_t*)(ws + OFF_IK); const float* iw = (const float*)(ws + OFF_IW);
    bf16_t* odsa = (bf16_t*)(ws + OFF_ODSA);
    unsigned short* Skey = (unsigned short*)lds;
    unsigned* Sel = (unsigned*)(lds + 131072);
    bf16_t* const KB0 = (bf16_t*)lds;
    bf16_t* const KB1 = (bf16_t*)(lds + 36864);
    const int tid = opaque_tid(), lane = tid & 63, wave = __builtin_amdgcn_readfirstlane(tid >> 6), lr = lane & 15, lq = lane >> 4;
    const int t0 = qt * 32;
    const size_t tokbase = (size_t)b * 2048;

    for (int repa = 0; repa < REP_A; repa++)
#pragma unroll 1
    for (int th = 0; th < 2; th++) {
        bf16x8 iqf[8][2];
        const bf16_t* iqrow = iq + (tokbase + t0 + th * 16 + lr) * 512 + lq * 8;
#pragma unroll
        for (int hh = 0; hh < 8; hh++) {
            iqf[hh][0] = *(const bf16x8*)(iqrow + hh * 64);
            iqf[hh][1] = *(const bf16x8*)(iqrow + hh * 64 + 32);
        }
        float wv[4][8];
#pragma unroll
        for (int r = 0; r < 4; r++) {
            const float4 a = *(const float4*)(iw + (tokbase + t0 + th * 16 + lq * 4 + r) * 8);
            const float4 c = *(const float4*)(iw + (tokbase + t0 + th * 16 + lq * 4 + r) * 8 + 4);
            wv[r][0] = a.x; wv[r][1] = a.y; wv[r][2] = a.z; wv[r][3] = a.w; wv[r][4] = c.x; wv[r][5] = c.y; wv[r][6] = c.z; wv[r][7] = c.w;
        }
        const int nsub = 2 * qt + 1 + th;
        const bf16_t* ikbase = ik + (tokbase + lr) * 64 + lq * 8;
        unsigned short* Srow = Skey + (th * 16 + lq * 4) * 2048 + lr;
        bf16x8 ka0 = bf16x8{0, 0, 0, 0, 0, 0, 0, 0}, ka1 = ka0, kb0 = ka0, kb1 = ka0;
        if (wave < nsub) { ka0 = *(const bf16x8*)(ikbase + (size_t)wave * 1024); ka1 = *(const bf16x8*)(ikbase + (size_t)wave * 1024 + 32); }
        if (wave + 8 < nsub) { kb0 = *(const bf16x8*)(ikbase + (size_t)(wave + 8) * 1024); kb1 = *(const bf16x8*)(ikbase + (size_t)(wave + 8) * 1024 + 32); }
        __builtin_amdgcn_s_waitcnt(0x0F70);
        for (int st = wave; st < nsub; st += 16) {
            const bf16x8 a0 = ka0, a1 = ka1, b0 = kb0, b1 = kb1;
            if (st + 16 < nsub) { ka0 = *(const bf16x8*)(ikbase + (size_t)(st + 16) * 1024); ka1 = *(const bf16x8*)(ikbase + (size_t)(st + 16) * 1024 + 32); }
            if (st + 24 < nsub) { kb0 = *(const bf16x8*)(ikbase + (size_t)(st + 24) * 1024); kb1 = *(const bf16x8*)(ikbase + (size_t)(st + 24) * 1024 + 32); }
            float sa[4] = {0.f, 0.f, 0.f, 0.f}, sb[4] = {0.f, 0.f, 0.f, 0.f};
#pragma unroll
            for (int hh = 0; hh < 8; hh++) {
                f32x4 xa = f32x4{0.f, 0.f, 0.f, 0.f}, xb = f32x4{0.f, 0.f, 0.f, 0.f};
                xa = mfma16(iqf[hh][0], a0, xa);
                xb = mfma16(iqf[hh][0], b0, xb);
                xa = mfma16(iqf[hh][1], a1, xa);
                xb = mfma16(iqf[hh][1], b1, xb);
#pragma unroll
                for (int r = 0; r < 4; r++) { sa[r] += fmaxf(xa[r], 0.f) * wv[r][hh]; sb[r] += fmaxf(xb[r], 0.f) * wv[r][hh]; }
            }
#pragma unroll
            for (int r = 0; r < 4; r++) Srow[r * 2048 + st * 16] = f2key(sa[r]);
            if (st + 8 < nsub) {
#pragma unroll
                for (int r = 0; r < 4; r++) Srow[r * 2048 + (st + 8) * 16] = f2key(sb[r]);
            }
        }
    }
    __syncthreads();

#pragma unroll 1
    for (int rr = 0; rr < 4 * REP_B; rr++) {
        const int tl = wave * 4 + (rr & 3);
        const int t = t0 + tl;
        const int nch = (t >> 6) + 1;
        unsigned key[32];
#pragma unroll
        for (int c = 0; c < 32; c++) {
            const int s = c * 64 + lane;
            key[c] = (s <= t) ? (unsigned)Skey[tl * 2048 + s] : 0u;
        }
        unsigned Tc = 1;
        int scut = t;
        if (t >= 256) {
            unsigned* hist = (unsigned*)(lds + 139392) + wave * 256;
            unsigned B1 = 0; int above1 = 0, neq = 0;
#pragma unroll 1
            for (int lvl = 0; lvl < 2; lvl++) {
                *(uint4*)(hist + lane * 4) = make_uint4(0u, 0u, 0u, 0u);
#pragma unroll
                for (int c4 = 0; c4 < 8; c4++)
                    if (c4 * 4 < nch) {
#pragma unroll
                        for (int c = c4 * 4; c < c4 * 4 + 4; c++) {
                            if (lvl == 0) atomicAdd(hist + (key[c] >> 8), 1u);
                            else if ((key[c] >> 8) == B1) atomicAdd(hist + (key[c] & 255u), 1u);
                        }
                    }
                const uint4 hb4 = *(const uint4*)(hist + lane * 4);
                const int sl = (int)(hb4.x + hb4.y + hb4.z + hb4.w);
                int v = sl;
                v += dpp_i<0x111>(v); v += dpp_i<0x112>(v); v += dpp_i<0x114>(v); v += dpp_i<0x118>(v);
                const int r0 = __builtin_amdgcn_readlane(v, 15), r1 = __builtin_amdgcn_readlane(v, 31), r2 = __builtin_amdgcn_readlane(v, 47), r3 = __builtin_amdgcn_readlane(v, 63);
                v += (lq >= 1 ? r0 : 0) + (lq >= 2 ? r1 : 0) + (lq >= 3 ? r2 : 0);
                const int total = r0 + r1 + r2 + r3;
                const int target = (lvl == 0) ? 256 : 256 - above1;
                const int sx = total - v;
                const bool owner = (sx < target) && (sx + sl >= target);
                int bin, abv;
                {
                    const int c3 = sx + (int)hb4.w, c2 = c3 + (int)hb4.z, c1 = c2 + (int)hb4.y;
                    if (c3 >= target) { bin = 3; abv = sx; }
                    else if (c2 >= target) { bin = 2; abv = c3; }
                    else if (c1 >= target) { bin = 1; abv = c2; }
                    else { bin = 0; abv = c1; }
                }
                const int cntb = bin == 3 ? (int)hb4.w : bin == 2 ? (int)hb4.z : bin == 1 ? (int)hb4.y : (int)hb4.x;
                const int src = __ffsll((long long)__ballot(owner)) - 1;
                const int obin = __builtin_amdgcn_readlane(bin, src) + 4 * src;
                const int oabv = __builtin_amdgcn_readlane(abv, src);
                if (lvl == 0) { B1 = (unsigned)obin; above1 = oabv; }
                else { Tc = (B1 << 8) | (unsigned)obin; above1 += oabv; neq = __builtin_amdgcn_readlane(cntb, src); }
            }
            const int need = 256 - above1;
            if (neq != need) {
                int cum = 0;
                bool found = false;
#pragma unroll
                for (int c = 0; c < 32; c++) {
                    const unsigned long long m = __ballot(key[c] == Tc);
                    const int pc = __popcll(m);
                    if (!found && cum + pc >= need) {
                        const int kth = need - cum;
                        const int pre = __popcll(m & ((2ull << lane) - 1ull));
                        const bool me = ((m >> lane) & 1ull) && (pre == kth);
                        const unsigned long long mm = __ballot(me);
                        scut = c * 64 + (__ffsll((long long)mm) - 1);
                        found = true;
                    }
                    cum += pc;
                }
            }
        }
        unsigned mlo = 0u, mhi = 0u;
#pragma unroll
        for (int c4 = 0; c4 < 8; c4++)
            if (c4 * 4 < nch) {
#pragma unroll
                for (int c = c4 * 4; c < c4 * 4 + 4; c++) {
                    const int s = c * 64 + lane;
                    const bool sel = (s <= t) && (key[c] > Tc || (key[c] == Tc && s <= scut));
                    const unsigned long long m = __ballot(sel);
                    if (lane == c) { mlo = (unsigned)m; mhi = (unsigned)(m >> 32); }
                }
            }
        if (lane < 32) { Sel[tl * 65 + lane * 2] = mlo; Sel[tl * 65 + lane * 2 + 1] = mhi; }
    }
    __syncthreads();

    for (int repc = 0; repc < REP_C; repc++) {
        const int hd = wave, g = wave >> 2;
        bf16x8 qf[2][2];
#pragma unroll
        for (int rg = 0; rg < 2; rg++) {
            qf[rg][0] = *(const bf16x8*)(dq + (tokbase + t0 + rg * 16 + lr) * 512 + hd * 64 + lq * 8);
            qf[rg][1] = *(const bf16x8*)(dq + (tokbase + t0 + rg * 16 + lr) * 512 + hd * 64 + 32 + lq * 8);
        }
        f32x4 oacc[2][4];
#pragma unroll
        for (int rg = 0; rg < 2; rg++)
#pragma unroll
            for (int n = 0; n < 4; n++) oacc[rg][n] = f32x4{0.f, 0.f, 0.f, 0.f};
        float m_run[2] = {-1e30f, -1e30f}, l_run[2] = {0.f, 0.f};
        const int ntile = (t0 + 31) / 64 + 1;
        const int tidc = opaque_tid();
        const int gg0 = tidc >> 9, gg1 = (tidc + 512) >> 9;
        const int sr = (tidc >> 3) & 63, scn = (tidc & 7) * 8;
        const bf16_t* kg0 = dk + (tokbase + sr) * 128 + gg0 * 64 + scn;
        const bf16_t* kg1 = dk + (tokbase + sr) * 128 + gg1 * 64 + scn;
        const bf16_t* vg0 = dvT + ((size_t)((b * 2 + gg0) * 64 + sr)) * 2048 + scn;
        const bf16_t* vg1 = dvT + ((size_t)((b * 2 + gg1) * 64 + sr)) * 2048 + scn;
        {
            const uint4 pk0 = *(const uint4*)kg0, pk1 = *(const uint4*)kg1, pv0 = *(const uint4*)vg0, pv1 = *(const uint4*)vg1;
            bf16_t* Vn = KB0 + 2 * 64 * LDP;
            *(uint4*)(KB0 + (gg0 * 64 + sr) * LDP + scn) = pk0;
            *(uint4*)(KB0 + (gg1 * 64 + sr) * LDP + scn) = pk1;
            *(uint4*)(Vn + (gg0 * 64 + sr) * LDP + scn) = pv0;
            *(uint4*)(Vn + (gg1 * 64 + sr) * LDP + scn) = pv1;
        }
        __builtin_amdgcn_s_waitcnt(0x0F70);
        __syncthreads();
        for (int kt = 0; kt < ntile; kt++) {
            const int j0 = kt * 64;
            uint4 pk0, pk1, pv0, pv1;
            if (kt + 1 < ntile) {
                pk0 = *(const uint4*)(kg0 + (size_t)(j0 + 64) * 128); pk1 = *(const uint4*)(kg1 + (size_t)(j0 + 64) * 128);
                pv0 = *(const uint4*)(vg0 + j0 + 64); pv1 = *(const uint4*)(vg1 + j0 + 64);
            }
            const bf16_t* Kc = (kt & 1) ? KB1 : KB0;
            const bf16_t* Vc = Kc + 2 * 64 * LDP;
            f32x4 lg[2][4];
#pragma unroll
            for (int rg = 0; rg < 2; rg++)
#pragma unroll
                for (int n = 0; n < 4; n++) lg[rg][n] = f32x4{0.f, 0.f, 0.f, 0.f};
#pragma unroll
            for (int ks = 0; ks < 2; ks++)
#pragma unroll
                for (int n = 0; n < 4; n++) {
                    const bf16x8 kf = *(const bf16x8*)(Kc + (g * 64 + n * 16 + lr) * LDP + ks * 32 + lq * 8);
                    lg[0][n] = mfma16(kf, qf[0][ks], lg[0][n]);
                    lg[1][n] = mfma16(kf, qf[1][ks], lg[1][n]);
                }
            bf16x8 pf[2][2];
#pragma unroll
            for (int rg = 0; rg < 2; rg++) {
                const unsigned* selrow = Sel + (rg * 16 + lr) * 65 + kt * 2;
                const unsigned w0 = selrow[0], w1 = selrow[1];
                float mx = -2e30f;
#pragma unroll
                for (int n = 0; n < 4; n++) {
                    const int wsh = (int)(((n < 2) ? w0 : w1) >> ((n & 1) * 16 + lq * 4));
#pragma unroll
                    for (int r = 0; r < 4; r++) {
                        const int msk = __builtin_amdgcn_sbfe(wsh, r, 1);
                        lg[rg][n][r] = __int_as_float((__float_as_int(lg[rg][n][r]) & msk) | (__float_as_int(-2e30f) & ~msk));
                        mx = fmaxf(mx, lg[rg][n][r]);
                    }
                }
                mx = lq_max(mx);
                const float m_new = fmaxf(m_run[rg], mx);
                const float alpha = __builtin_amdgcn_exp2f(m_run[rg] - m_new);
                float psum = 0.f;
#pragma unroll
                for (int n = 0; n < 4; n++)
#pragma unroll
                    for (int r = 0; r < 4; r++) { lg[rg][n][r] = __builtin_amdgcn_exp2f(lg[rg][n][r] - m_new); psum += lg[rg][n][r]; }
                psum = lq_sum(psum);
                l_run[rg] = l_run[rg] * alpha + psum;
                m_run[rg] = m_new;
#pragma unroll
                for (int n = 0; n < 4; n++) oacc[rg][n] = oacc[rg][n] * alpha;
#pragma unroll
                for (int ks = 0; ks < 2; ks++) {
                    const uint4 pu = make_uint4(pack2(lg[rg][2 * ks][0], lg[rg][2 * ks][1]), pack2(lg[rg][2 * ks][2], lg[rg][2 * ks][3]),
                                                pack2(lg[rg][2 * ks + 1][0], lg[rg][2 * ks + 1][1]), pack2(lg[rg][2 * ks + 1][2], lg[rg][2 * ks + 1][3]));
                    pf[rg][ks] = __builtin_bit_cast(bf16x8, pu);
                }
            }
#pragma unroll
            for (int ks = 0; ks < 2; ks++)
#pragma unroll
                for (int n = 0; n < 4; n++) {
                    const bf16_t* vrow = Vc + (g * 64 + n * 16 + lr) * LDP + ks * 32 + lq * 4;
                    const uint2 v0 = *(const uint2*)(vrow), v1 = *(const uint2*)(vrow + 16);
                    const bf16x8 vf = __builtin_bit_cast(bf16x8, make_uint4(v0.x, v0.y, v1.x, v1.y));
                    oacc[0][n] = mfma16(vf, pf[0][ks], oacc[0][n]);
                    oacc[1][n] = mfma16(vf, pf[1][ks], oacc[1][n]);
                }
            if (kt + 1 < ntile) {
                bf16_t* Kn = (kt & 1) ? KB0 : KB1;
                bf16_t* Vn = Kn + 2 * 64 * LDP;
                *(uint4*)(Kn + (gg0 * 64 + sr) * LDP + scn) = pk0;
                *(uint4*)(Kn + (gg1 * 64 + sr) * LDP + scn) = pk1;
                *(uint4*)(Vn + (gg0 * 64 + sr) * LDP + scn) = pv0;
                *(uint4*)(Vn + (gg1 * 64 + sr) * LDP + scn) = pv1;
            }
            __syncthreads();
        }
#pragma unroll
        for (int rg = 0; rg < 2; rg++) {
            const float inv = 1.f / l_run[rg];
#pragma unroll
            for (int n = 0; n < 4; n++)
                *(uint2*)(odsa + (tokbase + t0 + rg * 16 + lr) * 512 + hd * 64 + n * 16 + lq * 4) = pack4(oacc[rg][n] * inv);
        }
    }
}

DEVINL void phase_mixers(const KParams& p, unsigned char* lds) {
    const int G = gridDim.x;
    for (int r = 0; r * G < 512; r++) {
        const int idx = r * G + ((r & 1) ? (G - 1 - (int)blockIdx.x) : (int)blockIdx.x);
        if (idx < 512) dsa_unit(p, lds, idx & 7, 63 - (idx >> 3));
    }
    __syncthreads();
    for (int u = blockIdx.x; u < 1024; u += G) {
        const int qt = 31 - (u >> 5), rest = u & 31;
        for (int reps = 0; reps < REP_SB; reps++) sb_unit(p, lds, rest >> 2, rest & 3, qt);
    }
}

DEVINL void phase_merge(const KParams& p, unsigned char* lds) {
    unsigned char* ws = p.ws;
    static_assert(OFF_ODSA == OFF_OSB + 16 * MB && OFF_WTDSA == OFF_WTSB + 1 * MB, "the stacked operands must be contiguous");
    pg8::Gemm g{(const bf16_t*)(ws + OFF_OSB), (const bf16_t*)(ws + OFF_WTSB), 32768, 2048, 512};
    MergeOrder S; S.S.init(16384, 1024, (int)gridDim.x, (int)blockIdx.x);
    EpiMerge2 E{(const bf16_t*)(ws + OFF_GATES), (bf16_t*)(ws + OFF_MERGED)};
    pg8::gemm_phase<EpiMerge2, MergeOrder, true, true>((lds_ptr_t)lds, g, S, E);
}

DEVINL void phase_resid(const KParams& p, unsigned char* lds, const bf16_t* A, int K, const bf16_t* Wt, const float* res32, float* rowss) {
    if (res32) { EpiResid<true> E{res32, (bf16_t*)(p.ws + OFF_HB), rowss}; run_gemm<EpiResid<true>, true>(lds, A, Wt, 16384, 1024, K, E); }
    else { EpiResid<false> E{nullptr, (bf16_t*)(p.ws + OFF_HB), rowss}; run_gemm<EpiResid<false>, true>(lds, A, Wt, 16384, 1024, K, E); }
}

DEVINL void phase_down_final(const KParams& p, unsigned char* lds) {
    unsigned char* ws = p.ws;
    EpiFinal E{(const bf16_t*)(ws + OFF_HB), p.out, p.in[17], (float*)(ws + OFF_BAR + 32768), (unsigned*)(ws + OFF_BAR + 16384)};
    run_gemm<EpiFinal, false>(lds, (const bf16_t*)(ws + OFF_HDN), (const bf16_t*)(ws + OFF_WTDOWN), 16384, 1024, 4096, E);
}

DEVINL void phase_cq(const KParams& p, unsigned char* lds) {
    unsigned char* ws = p.ws;
    EpiCq E{(const float*)(ws + OFF_ROWSS), (bf16_t*)(ws + OFF_QC)};
    run_gemm<EpiCq, true>(lds, (const bf16_t*)(ws + OFF_HB), (const bf16_t*)(ws + OFF_WTCQ), 16384, 512, 1024, E);
    EpiMemKV E2{(bf16_t*)(ws + OFF_KMEM), (bf16_t*)(ws + OFF_VMEMT)};
    const int G = gridDim.x;
    int c = (int)blockIdx.x;
    if (G >= 160) c = (c >= 128) ? c - 128 : (1 << 20);
    run_gemm<EpiMemKV, true>(lds, (const bf16_t*)(ws + OFF_MEMN), (const bf16_t*)(ws + OFF_WTCKV), 2048, 1024, 1024, E2, c);
    const int first = (G >= 192) ? 160 : 0;
    float* tile = (float*)lds;
    transpose_job(p.in[13], 512, 1024, 1024, (bf16_t*)(ws + OFF_WTCO), nullptr, tile, false, 0, first);
    transpose_job(p.in[15], 1024, 4096, 4096, (bf16_t*)(ws + OFF_WTUP), p.in[14], tile, false, 0, first);
    transpose_job(p.in[16], 4096, 1024, 1024, (bf16_t*)(ws + OFF_WTDOWN), nullptr, tile, false, 0, first);
}

DEVINL void cross_unit(const KParams& p, unsigned char* lds, int rt2, int h) {
    unsigned char* ws = p.ws;
    const bf16_t* qc = (const bf16_t*)(ws + OFF_QC); const bf16_t* kmem = (const bf16_t*)(ws + OFF_KMEM); const bf16_t* vmemT = (const bf16_t*)(ws + OFF_VMEMT);
    bf16_t* oc = (bf16_t*)(ws + OFF_OC);
    bf16_t* Kl = (bf16_t*)lds;
    bf16_t* Vl = Kl + 256 * 136;
    const int tid = opaque_tid(), lane = tid & 63, wave = __builtin_amdgcn_readfirstlane(tid >> 6), lr = lane & 15, lq = lane >> 4;
    const int b = (rt2 * 256) >> 11;
    bf16x8 qfa[2][4];
#pragma unroll
    for (int half = 0; half < 2; half++) {
        const bf16_t* qrow = qc + (size_t)(rt2 * 256 + half * 128 + wave * 16 + lr) * 512 + h * 128 + lq * 8;
#pragma unroll
        for (int ks = 0; ks < 4; ks++) qfa[half][ks] = *(const bf16x8*)(qrow + ks * 32);
    }
#pragma unroll
    for (int i = 0; i < 8; i++) {
        const int id = tid + i * 512, r = id >> 4, c = (id & 15) * 8;
        *(uint4*)(Kl + r * 136 + c) = *(const uint4*)(kmem + (size_t)(b * 256 + r) * 512 + h * 128 + c);
    }
#pragma unroll
    for (int i = 0; i < 8; i++) {
        const int id = tid + i * 512, r = id >> 5, c = (id & 31) * 8;
        *(uint4*)(Vl + r * 264 + c) = *(const uint4*)(vmemT + ((size_t)((b * 4 + h) * 128 + r)) * 256 + c);
    }
    __syncthreads();
#pragma unroll
    for (int half = 0; half < 2; half++) {
    const int row0 = rt2 * 256 + half * 128;
    bf16x8 qf[4];
#pragma unroll
    for (int ks = 0; ks < 4; ks++) qf[ks] = qfa[half][ks];
    f32x4 s[16];
#pragma unroll
    for (int n = 0; n < 16; n++) s[n] = f32x4{0.f, 0.f, 0.f, 0.f};
#pragma unroll
    for (int ks = 0; ks < 4; ks++)
#pragma unroll
        for (int n = 0; n < 16; n++) {
            const bf16x8 kf = *(const bf16x8*)(Kl + (n * 16 + lr) * 136 + ks * 32 + lq * 8);
            s[n] = mfma16(kf, qf[ks], s[n]);
            if ((n & 7) == 7) __builtin_amdgcn_sched_barrier(0);
        }
    float mx = -3e38f;
#pragma unroll
    for (int n = 0; n < 16; n++) mx = fmaxf(mx, fmaxf(fmaxf(s[n][0], s[n][1]), fmaxf(s[n][2], s[n][3])));
    mx = lq_max(mx);
    float sum = 0.f;
#pragma unroll
    for (int n = 0; n < 16; n++)
#pragma unroll
        for (int r = 0; r < 4; r++) { s[n][r] = __builtin_amdgcn_exp2f(s[n][r] - mx); sum += s[n][r]; }
    sum = lq_sum(sum);
    f32x4 o[8];
#pragma unroll
    for (int n = 0; n < 8; n++) o[n] = f32x4{0.f, 0.f, 0.f, 0.f};
#pragma unroll
    for (int ks = 0; ks < 8; ks++) {
        const uint4 pu = make_uint4(pack2(s[2 * ks][0], s[2 * ks][1]), pack2(s[2 * ks][2], s[2 * ks][3]),
                                    pack2(s[2 * ks + 1][0], s[2 * ks + 1][1]), pack2(s[2 * ks + 1][2], s[2 * ks + 1][3]));
        const bf16x8 pf = __builtin_bit_cast(bf16x8, pu);
#pragma unroll
        for (int n = 0; n < 8; n++) {
            const bf16_t* vrow = Vl + (n * 16 + lr) * 264 + ks * 32 + lq * 4;
            const uint2 v0 = *(const uint2*)(vrow), v1 = *(const uint2*)(vrow + 16);
            const bf16x8 vf = __builtin_bit_cast(bf16x8, make_uint4(v0.x, v0.y, v1.x, v1.y));
            o[n] = mfma16(vf, pf, o[n]);
        }
        __builtin_amdgcn_sched_barrier(0);
    }
    const float inv = __builtin_amdgcn_rcpf(sum);
#pragma unroll
    for (int n = 0; n < 8; n++)
        *(uint2*)(oc + (size_t)(row0 + wave * 16 + lr) * 512 + h * 128 + n * 16 + lq * 4) = pack4(o[n] * inv);
    }
    __syncthreads();
}

DEVINL void phase_up(const KParams& p, unsigned char* lds) {
    unsigned char* ws = p.ws;
    EpiUp E{(const float*)(ws + OFF_ROWSS) + 16384, (bf16_t*)(ws + OFF_HDN)};
    run_gemm<EpiUp, true>(lds, (const bf16_t*)(ws + OFF_HB), (const bf16_t*)(ws + OFF_WTUP), 16384, 4096, 1024, E);
}

DEVINL void phase_final(const KParams& p) {
    const bf16_t* hb = (const bf16_t*)(p.ws + OFF_HB);
    const float* rowss3 = (const float*)(p.ws + OFF_ROWSS) + 32768;
    const float* g = p.in[17];
    for (int i = blockIdx.x * NTHREADS + threadIdx.x; i < 16384 * 128; i += gridDim.x * NTHREADS) {
        const int row = i >> 7, col = (i & 127) * 8;
        const float rs = rsqrtf(rowss3[row] * (1.f / 1024.f) + EPS);
        const uint4 o = *(const uint4*)(hb + (size_t)row * 1024 + col);
        const float4 g0 = *(const float4*)(g + col), g1 = *(const float4*)(g + col + 4);
        float* dst = p.out + (size_t)row * 1024 + col;
        *(float4*)dst = make_float4(bf2f(o.x & 0xffffu) * rs * g0.x, bf2f(o.x >> 16) * rs * g0.y, bf2f(o.y & 0xffffu) * rs * g0.z, bf2f(o.y >> 16) * rs * g0.w);
        *(float4*)(dst + 4) = make_float4(bf2f(o.z & 0xffffu) * rs * g1.x, bf2f(o.z >> 16) * rs * g1.y, bf2f(o.w & 0xffffu) * rs * g1.z, bf2f(o.w >> 16) * rs * g1.w);
    }
}

__global__ void __launch_bounds__(NTHREADS, 2) mega_fwd(KParams p) {
    extern __shared__ __attribute__((aligned(16))) unsigned char lds[];
    cg::grid_group grid = cg::this_grid();
    unsigned char* ws = p.ws;
    float* rowss = (float*)(ws + OFF_ROWSS);
    if (p.ph_lo > p.ph_hi) grid.sync();
    volatile LAS unsigned* xst = (volatile LAS unsigned*)((lds_ptr_t)lds + LDS_BYTES - 16);
    if (threadIdx.x < 4) xst[threadIdx.x] = 0u;
    __syncthreads();
    XcdBarrier xb = xcd_barrier_post((unsigned*)(ws + OFF_BAR), xst);
#ifndef PROBE_DUP
#define PROBE_DUP -1
#endif
#define RUN_PHASE(k, body) if (p.ph_lo <= (k) && (k) < p.ph_hi) { body; if ((k) == PROBE_DUP) { xcd_barrier(xb); body; } if ((k) + 1 < p.ph_hi) xcd_barrier(xb); }
    RUN_PHASE(0, phase_prep(p, lds))
    RUN_PHASE(1, phase_inproj(p, lds))
    RUN_PHASE(2, phase_mixers(p, lds))
    RUN_PHASE(3, phase_merge(p, lds))
    RUN_PHASE(4, phase_resid(p, lds, (const bf16_t*)(ws + OFF_MERGED), 1024, (const bf16_t*)(ws + OFF_WTOUT), p.in[0], rowss))
    RUN_PHASE(5, phase_cq(p, lds))
    RUN_PHASE(6, for (int u = blockIdx.x; u < 256; u += gridDim.x) cross_unit(p, lds, u >> 2, u & 3))
    RUN_PHASE(7, phase_resid(p, lds, (const bf16_t*)(ws + OFF_OC), 512, (const bf16_t*)(ws + OFF_WTCO), nullptr, rowss + 16384))
    RUN_PHASE(8, phase_up(p, lds))
    if (gridDim.x == 256) {
        if (p.ph_lo <= 9 && 9 < p.ph_hi) phase_down_final(p, lds);
    } else {
        RUN_PHASE(9, phase_resid(p, lds, (const bf16_t*)(ws + OFF_HDN), 4096, (const bf16_t*)(ws + OFF_WTDOWN), nullptr, rowss + 32768))
        RUN_PHASE(10, phase_final(p))
    }
}

extern "C" void kernel_launch(void* const* d_in, const int* in_sizes, int n_in, void* d_out, int out_size, void* d_ws, size_t ws_size, hipStream_t stream) {
    static int grid = 0;
    if (grid == 0) {
        if (n_in != 18 || out_size != 16384 * 1024 || ws_size < WS_END) {
            fprintf(stderr, "kernel_launch: unexpected problem (n_in %d, out %d, ws %zu, need %zu)\n", n_in, out_size, ws_size, (size_t)WS_END);
            grid = -1; return;
        }
        int dev = 0, cus = 0, per_cu = 0;
        hipGetDevice(&dev);
        hipDeviceGetAttribute(&cus, hipDeviceAttributeMultiprocessorCount, dev);
        if (hipFuncSetAttribute((const void*)mega_fwd, hipFuncAttributeMaxDynamicSharedMemorySize, LDS_BYTES) != hipSuccess) {
            fprintf(stderr, "kernel_launch: hipFuncSetAttribute failed\n"); grid = -1; return;
        }
        if (hipOccupancyMaxActiveBlocksPerMultiprocessor(&per_cu, (const void*)mega_fwd, NTHREADS, LDS_BYTES) != hipSuccess || per_cu < 1) {
            fprintf(stderr, "kernel_launch: occupancy query says %d blocks per CU\n", per_cu);
            per_cu = 1;
        }
        (void)hipGetLastError();
        grid = cus;
    }
    if (grid < 0) return;
    if (hipMemsetAsync((unsigned char*)d_ws + OFF_BAR, 0, 16384 + 256, stream) != hipSuccess) { fprintf(stderr, "kernel_launch: memset of the barrier words failed\n"); return; }
    KParams p{};
    for (int i = 0; i < 18; i++) p.in[i] = (const float*)d_in[i];
    p.out = (float*)d_out;
    p.ws = (unsigned char*)d_ws;
    p.ph_lo = 0; p.ph_hi = 11;
    void* args[] = {&p};
    hipError_t e = hipLaunchCooperativeKernel((const void*)mega_fwd, dim3(grid), dim3(NTHREADS), args, LDS_BYTES, stream);
    if (e != hipSuccess) fprintf(stderr, "kernel_launch: cooperative launch failed: %s (grid %d)\n", hipGetErrorString(e), grid);
}
```
